# Optimizing an MI355X kernel written in HIP

```python
import jax, jax.numpy as jnp
from jax import lax
import numpy as np

D_MODEL = 2048
BATCH = 2
SEQ = 4096
DEPTH = 1

D_MIX = D_MODEL
RET_HEADS = 8
RET_DK = 128
RET_DV = 128
RET_QK_WIDTH = RET_HEADS * RET_DK
RET_WIDTH = RET_HEADS * RET_DV
RET_CHUNK = 128
SWA_HEADS = 16
SWA_KV_HEADS = 2
SWA_HEAD_DIM = 64
SWA_WIDTH = SWA_HEADS * SWA_HEAD_DIM
SWA_KV_WIDTH = SWA_KV_HEADS * SWA_HEAD_DIM
WINDOW = 128
MEM_LEN = 256
XA_HEADS = 4
XA_HEAD_DIM = D_MODEL // XA_HEADS
D_FF = 5632
ROPE_THETA = 10000.0
EPS = 1e-6

IN_SIZES = [RET_QK_WIDTH, RET_QK_WIDTH, RET_WIDTH, RET_WIDTH, SWA_WIDTH, SWA_KV_WIDTH, SWA_KV_WIDTH]
IN_COLS = sum(IN_SIZES)
IN_SPLITS = [int(v) for v in np.cumsum(IN_SIZES)[:-1]]

kernel_name = "hymba_retention_swa_macaron_block"


def rms_norm(x, g):
    xf = x.astype(jnp.float32)
    y = xf * lax.rsqrt(jnp.mean(xf * xf, axis=-1, keepdims=True) + EPS)
    return (y * g.astype(jnp.float32)).astype(x.dtype)


def rope(x, pos):
    d = x.shape[-1]
    inv_freq = ROPE_THETA ** (-jnp.arange(0, d, 2, dtype=jnp.float32) / d)
    ang = pos[:, None] * inv_freq[None, :]
    cos = jnp.cos(ang)[None, :, None, :]
    sin = jnp.sin(ang)[None, :, None, :]
    xf = x.astype(jnp.float32)
    x1, x2 = xf[..., : d // 2], xf[..., d // 2:]
    out = jnp.concatenate([x1 * cos - x2 * sin, x2 * cos + x1 * sin], axis=-1)
    return out.astype(x.dtype)


def swiglu(x, w_gate, w_up, w_down):
    return (jax.nn.silu(x @ w_gate) * (x @ w_up)) @ w_down


def retention(q, k, v):
    B, S, H, dk = q.shape
    dv = v.shape[-1]
    C = RET_CHUNK
    N = S // C
    f32 = jnp.float32
    log_gamma = jnp.log1p(-jnp.exp2(-5.0 - jnp.arange(H, dtype=f32)))
    qc = q.astype(f32).reshape(B, N, C, H, dk)
    kc = (k.astype(f32) * (dk ** -0.5)).reshape(B, N, C, H, dk)
    vc = v.astype(f32).reshape(B, N, C, H, dv)
    idx = jnp.arange(C, dtype=f32)
    diff = idx[:, None] - idx[None, :]
    dmat = jnp.where(diff[None] >= 0,
                     jnp.exp(jnp.maximum(diff, 0.0)[None] * log_gamma[:, None, None]),
                     0.0)
    s = jnp.einsum('bnchd,bnjhd->bnhcj', qc, kc) * dmat[None, None]
    intra = jnp.einsum('bnhcj,bnjhe->bnche', s, vc)
    zeta = jnp.exp((C - 1.0 - idx)[None, :] * log_gamma[:, None])
    kv = jnp.einsum('bnjhd,hj,bnjhe->nbhde', kc, zeta, vc)
    chunk_decay = jnp.exp(C * log_gamma)[None, :, None, None]

    def step(state, kv_n):
        return state * chunk_decay + kv_n, state

    _, prev_states = lax.scan(step, jnp.zeros((B, H, dk, dv), f32), kv)
    xi = jnp.exp((idx + 1.0)[None, :] * log_gamma[:, None])
    cross = jnp.einsum('bnchd,hc,nbhde->bnche', qc, xi, prev_states)
    return (intra + cross).reshape(B, S, H, dv)


def sliding_window_attention(q, k, v, sinks):
    B, S, Hq, d = q.shape
    Hkv = k.shape[2]
    G = Hq // Hkv
    W = WINDOW
    N = S // W
    qb = q.reshape(B, N, W, Hkv, G, d)
    kb = k.reshape(B, N, W, Hkv, d)
    vb = v.reshape(B, N, W, Hkv, d)
    kk = jnp.concatenate([jnp.concatenate([jnp.zeros_like(kb[:, :1]), kb[:, :-1]], axis=1), kb], axis=2)
    vv = jnp.concatenate([jnp.concatenate([jnp.zeros_like(vb[:, :1]), vb[:, :-1]], axis=1), vb], axis=2)
    s = jnp.einsum('bnqhgd,bnkhd->bnhgqk', qb, kk).astype(jnp.float32) * (d ** -0.5)
    qi = jnp.arange(W)[:, None] + W
    ki = jnp.arange(2 * W)[None, :]
    rel = qi - ki
    band = (rel >= 0) & (rel < W)
    valid = band[None] & ((jnp.arange(N)[:, None, None] > 0) | (ki[None] >= W))
    s = jnp.where(valid[None, :, None, None], s, jnp.finfo(jnp.float32).min)
    sink = sinks.astype(jnp.float32).reshape(Hkv, G)[None, None, :, :, None, None]
    m = jnp.maximum(jnp.max(s, axis=-1, keepdims=True), sink)
    p = jnp.exp(s - m)
    probs = p / (jnp.sum(p, axis=-1, keepdims=True) + jnp.exp(sink - m))
    o = jnp.einsum('bnhgqk,bnkhd->bnqhgd', probs.astype(v.dtype), vv)
    return o.reshape(B, S, Hq * d)


def memory_cross_attention(hn, memn, wq, wkv, wo):
    B, S, D = hn.shape
    M = memn.shape[1]
    q = (hn @ wq).reshape(B, S, XA_HEADS, XA_HEAD_DIM)
    k, v = jnp.split(memn @ wkv, 2, axis=-1)
    k = k.reshape(B, M, XA_HEADS, XA_HEAD_DIM)
    v = v.reshape(B, M, XA_HEADS, XA_HEAD_DIM)
    s = jnp.einsum('bshd,bmhd->bhsm', q, k).astype(jnp.float32) * (XA_HEAD_DIM ** -0.5)
    p = jax.nn.softmax(s, axis=-1)
    o = jnp.einsum('bhsm,bmhd->bshd', p.astype(v.dtype), v).reshape(B, S, D)
    return o @ wo


def setup_inputs(seed: int = 0) -> dict:
    key = jax.random.key(seed)
    ks = jax.random.split(key, 24)
    f32 = jnp.float32
    L, D = DEPTH, D_MODEL

    def w(k, shape, fan_in):
        return jax.random.normal(k, shape, f32) * (fan_in ** -0.5)

    def gain(k, shape):
        return 1.0 + 0.02 * jax.random.normal(k, shape, f32)

    return {
        "x": jax.random.normal(ks[0], (BATCH, SEQ, D), f32),
        "mem": jax.random.normal(ks[1], (BATCH, MEM_LEN, D), f32),
        "ffn1_norm": gain(ks[2], (L, D)),
        "ffn1_w_gate": w(ks[3], (L, D, D_FF), D),
        "ffn1_w_up": w(ks[4], (L, D, D_FF), D),
        "ffn1_w_down": w(ks[5], (L, D_FF, D), D_FF),
        "mix_norm": gain(ks[6], (L, D)),
        "w_in": w(ks[7], (L, D, IN_COLS), D),
        "ret_gn_gain": gain(ks[8], (L, RET_WIDTH)),
        "swa_sinks": 0.5 * jax.random.normal(ks[9], (L, SWA_HEADS), f32),
        "w_out": w(ks[10], (L, D_MIX, D), D_MIX),
        "xa_norm": gain(ks[11], (L, D)),
        "mem_norm": gain(ks[12], (L, D)),
        "xa_wq": w(ks[13], (L, D, D), D),
        "xa_wkv": w(ks[14], (L, D, 2 * D), D),
        "xa_wo": w(ks[15], (L, D, D), D),
        "ffn2_norm": gain(ks[16], (L, D)),
        "ffn2_w_gate": w(ks[17], (L, D, D_FF), D),
        "ffn2_w_up": w(ks[18], (L, D, D_FF), D),
        "ffn2_w_down": w(ks[19], (L, D_FF, D), D_FF),
        "final_norm": gain(ks[20], (D,)),
    }


def reference(x, mem, ffn1_norm, ffn1_w_gate, ffn1_w_up, ffn1_w_down, mix_norm, w_in, ret_gn_gain,
              swa_sinks, w_out, xa_norm, mem_norm, xa_wq, xa_wkv, xa_wo, ffn2_norm, ffn2_w_gate,
              ffn2_w_up, ffn2_w_down, final_norm):
    B, S, _ = x.shape
    pos = jnp.arange(S, dtype=jnp.float32)
    h = x
    for l in range(DEPTH):
        h = h + 0.5 * swiglu(rms_norm(h, ffn1_norm[l]), ffn1_w_gate[l], ffn1_w_up[l], ffn1_w_down[l])

        n = rms_norm(h, mix_norm[l])
        rq, rk, rv, rg, sq, sk, sv = jnp.split(n @ w_in[l], IN_SPLITS, axis=-1)

        rq = rope(rq.reshape(B, S, RET_HEADS, RET_DK), pos)
        rk = rope(rk.reshape(B, S, RET_HEADS, RET_DK), pos)
        ret = retention(rq, rk, rv.reshape(B, S, RET_HEADS, RET_DV))
        mu = jnp.mean(ret, axis=-1, keepdims=True)
        var = jnp.mean(jnp.square(ret - mu), axis=-1, keepdims=True)
        ret = (ret - mu) * lax.rsqrt(var + EPS) * ret_gn_gain[l].astype(jnp.float32).reshape(RET_HEADS, RET_DV)
        ret = (jax.nn.silu(rg.astype(jnp.float32)) * ret.reshape(B, S, RET_WIDTH)).astype(h.dtype)

        sq = rope(sq.reshape(B, S, SWA_HEADS, SWA_HEAD_DIM), pos)
        sk = rope(sk.reshape(B, S, SWA_KV_HEADS, SWA_HEAD_DIM), pos)
        swa = sliding_window_attention(sq, sk, sv.reshape(B, S, SWA_KV_HEADS, SWA_HEAD_DIM), swa_sinks[l])

        h = h + jnp.concatenate([ret, swa.astype(h.dtype)], axis=-1) @ w_out[l]

        h = h + memory_cross_attention(rms_norm(h, xa_norm[l]), rms_norm(mem, mem_norm[l]),
                                       xa_wq[l], xa_wkv[l], xa_wo[l])

        h = h + 0.5 * swiglu(rms_norm(h, ffn2_norm[l]), ffn2_w_gate[l], ffn2_w_up[l], ffn2_w_down[l])
    return rms_norm(h, final_norm)
```

```cpp
#include <hip/hip_runtime.h>
#include <hip/hip_cooperative_groups.h>
#include <cstdio>
#include <cstdint>
namespace cg = cooperative_groups;
#define MK_SINGLE 1
#ifndef PG8_WGM
#define PG8_WGM 8
#endif
#ifndef PG8_ROT
#define PG8_ROT 0
#endif
#ifndef PG8_BAUX
#define PG8_BAUX 0
#endif
namespace pg8 {
#define PG8_LAS __attribute__((address_space(3)))
typedef unsigned short bf16_t;
typedef short bf16x8 __attribute__((ext_vector_type(8)));
typedef float f32x4 __attribute__((ext_vector_type(4)));
typedef unsigned u32x4 __attribute__((ext_vector_type(4)));
constexpr int BM = 256, BK = 64, HALF = 128, HTB = HALF * BK * 2  , STAGE_BYTES = 8 * HTB, NXCD = 8, WGM = PG8_WGM;

__host__ __device__ __forceinline__ int lds_byte(int r, int c) { const int st = (r >> 4) * 2 + (c >> 5), rr = r & 15, cc = c & 31, ob = rr * 64 + cc * 2; return st * 1024 + (ob ^ (((ob >> 9) & 1) << 5)); }
__host__ __device__ __forceinline__ void stage_rc(int b, int& R, int& C) { const int st = b / 1024, sb = b % 1024, swz = sb ^ (((sb >> 9) & 1) << 5); R = (st >> 1) * 16 + swz / 64; C = (st & 1) * 32 + (swz % 64) / 2; }
__host__ __device__ __forceinline__ int perm32(int rho) { const int n = rho >> 4, i = rho & 15; return 8 * (i >> 2) + 4 * n + (i & 3); }

struct Unit { int pm, pn; };
struct Gemm { const bf16_t* A; const bf16_t* Bt; int M, N, K; };

struct StaticOrder {
    int nM, nN, nwg, G, c;
    __host__ __device__ void init(int M, int N, int G_, int c_) { nM = M / BM; nN = N / BM; nwg = nM * nN; G = G_; c = c_; }
    __host__ __device__ bool next(int i, Unit& u) const {
        const long L = (long)i * G + c; if (L >= nwg) return false;
        int wgid = (int)L; { const int q = nwg / NXCD, r = nwg % NXCD, xcd = wgid % NXCD, off = wgid / NXCD; wgid = (xcd < r ? xcd * (q + 1) : r * (q + 1) + (xcd - r) * q) + off; }
        const int nig = WGM * nN, gid = wgid / nig, fm = gid * WGM, gsz = (nM - fm) < WGM ? (nM - fm) : WGM;
        u.pm = fm + ((wgid % nig) % gsz); u.pn = (wgid % nig) / gsz;
#if PG8_ROT
        if (nM == 32 && (nN & 1) == 0 && nN >= 16 && nwg % NXCD == 0) { const int xcd = (int)(L % NXCD), half = nN / 2, base = (xcd & 1) * half; u.pn = base + (u.pn - base + (xcd >> 1) * (half / 4)) % half; }
#endif
        return true;
    }
    __device__ __forceinline__ void a_ready(const Unit&) const {}
    __device__ __forceinline__ void done(const Unit&) const {}
};

template <class Epi, class Sched, bool ALIGN_EPI = false, bool SP2 = false>
__device__ __forceinline__ void gemm_phase(PG8_LAS unsigned char* lds, const Gemm g, const Sched& S, const Epi& E) {
    const int tid = threadIdx.x, wid = __builtin_amdgcn_readfirstlane(tid >> 6), lane = tid & 63, wr = wid >> 2, wc = wid & 3, fr = lane & 15, fq = lane >> 4;
    const int K = g.K, nt = K / BK;
    unsigned voffA[2], voffB[2];
#pragma unroll
    for (int i = 0; i < 2; ++i) { int R, C; stage_rc(tid * 16 + i * 8192, R, C); const int Rb = Epi::PERM ? ((R & ~31) + perm32(R & 31)) : R;
        voffA[i] = (unsigned)(R * K + C) * 2u; voffB[i] = (unsigned)(Rb * K + C) * 2u; }
    const size_t kstep = (size_t)(BK * 2);
    const size_t hstep = (size_t)HALF * K * 2;
    const size_t tstep = 2 * hstep;
    const unsigned ldsw = (unsigned)wid * 1024u;
    const int aoff = lds_byte(wr * 64 + fr, fq * 8), boff = lds_byte(wc * 32 + fr, fq * 8);
#define PG8_SA(b, h) (((b) * 2 + (h)) * HTB)
#define PG8_SB(b, h) ((4 + (b) * 2 + (h)) * HTB)
#define PG8_STAGE(bufoff, gbase, voff) do { _Pragma("unroll") for (int _i = 0; _i < 2; ++_i) \
        __builtin_amdgcn_global_load_lds((const unsigned*)((const char*)(gbase) + (voff)[_i]), (PG8_LAS unsigned*)(lds + (bufoff) + ldsw + _i * 8192), 16, 0, 0); } while (0)
#define PG8_STAGEB(bufoff, gbase, voff) do { _Pragma("unroll") for (int _i = 0; _i < 2; ++_i) \
        __builtin_amdgcn_global_load_lds((const unsigned*)((const char*)(gbase) + (voff)[_i]), (PG8_LAS unsigned*)(lds + (bufoff) + ldsw + _i * 8192), 16, 0, PG8_BAUX); } while (0)
#define PG8_LDA(dst, b, h) do { _Pragma("unroll") for (int m = 0; m < 4; ++m) _Pragma("unroll") for (int k = 0; k < 2; ++k) dst[m][k] = *(const PG8_LAS bf16x8*)(lds + PG8_SA(b, h) + aoff + m * 2048 + k * 1024); } while (0)
#define PG8_LDB(dst, b, h) do { _Pragma("unroll") for (int n = 0; n < 2; ++n) _Pragma("unroll") for (int k = 0; k < 2; ++k) dst[n][k] = *(const PG8_LAS bf16x8*)(lds + PG8_SB(b, h) + boff + n * 2048 + k * 1024); } while (0)
#define PG8_MMA(ai, bj, At, Bt) do { __builtin_amdgcn_s_setprio(1); _Pragma("unroll") for (int m = 0; m < 4; ++m) _Pragma("unroll") for (int n = 0; n < 2; ++n) _Pragma("unroll") for (int k = 0; k < 2; ++k) \
        acc[ai][bj][m][n] = __builtin_amdgcn_mfma_f32_16x16x32_bf16(Bt[n][k], At[m][k], acc[ai][bj][m][n], 0, 0, 0); __builtin_amdgcn_s_setprio(0); } while (0)
#define PG8_WAIT_V(n) asm volatile("s_waitcnt vmcnt(" #n ")" ::: "memory")
#define PG8_WAIT_L(n) asm volatile("s_waitcnt lgkmcnt(" #n ")" ::: "memory")
#define PG8_BAR __builtin_amdgcn_s_barrier()
#define PG8_SCHED __builtin_amdgcn_sched_barrier(0)
    Unit cur, nxt; int ui = 0;
    if (!S.next(0, cur)) return;
    f32x4 acc[2][2][4][2];
#pragma unroll
    for (int a = 0; a < 2; ++a)
#pragma unroll
        for (int b = 0; b < 2; ++b)
#pragma unroll
            for (int m = 0; m < 4; ++m)
#pragma unroll
                for (int n = 0; n < 2; ++n) acc[a][b][m][n] = (f32x4){0.f, 0.f, 0.f, 0.f};
    bf16x8 At[4][2], B0[2][2], B1[2][2];
    const char* cA = (const char*)g.A + (size_t)cur.pm * tstep; const char* cB = (const char*)g.Bt + (size_t)cur.pn * tstep;
    S.a_ready(cur);
    if constexpr (SP2) {
        PG8_STAGEB(PG8_SB(0, 0), cB, voffB); PG8_STAGEB(PG8_SB(0, 1), cB + hstep, voffB); PG8_STAGE(PG8_SA(0, 0), cA, voffA); PG8_STAGE(PG8_SA(0, 1), cA + hstep, voffA);
        if (wr == 1) PG8_BAR;
        PG8_WAIT_V(2); PG8_BAR;
        PG8_STAGEB(PG8_SB(1, 0), cB + kstep, voffB); PG8_STAGE(PG8_SA(1, 0), cA + kstep, voffA); PG8_STAGEB(PG8_SB(1, 1), cB + hstep + kstep, voffB);
        PG8_WAIT_V(6); PG8_BAR;
    } else {
        PG8_STAGEB(PG8_SB(0, 0), cB, voffB); PG8_STAGE(PG8_SA(0, 0), cA, voffA); PG8_STAGEB(PG8_SB(0, 1), cB + hstep, voffB); PG8_STAGE(PG8_SA(0, 1), cA + hstep, voffA);
        if (wr == 1) PG8_BAR;
        PG8_WAIT_V(4); PG8_BAR;
        PG8_STAGEB(PG8_SB(1, 0), cB + kstep, voffB); PG8_STAGE(PG8_SA(1, 0), cA + kstep, voffA); PG8_STAGEB(PG8_SB(1, 1), cB + hstep + kstep, voffB);
        PG8_WAIT_V(6); PG8_BAR;
    }
    for (;;) {
        const bool has_next = S.next(ui + 1, nxt);
        const char* nA = has_next ? (const char*)g.A + (size_t)nxt.pm * tstep : cA; const char* nB = has_next ? (const char*)g.Bt + (size_t)nxt.pn * tstep : cB;
        for (int t = 0; t < nt; t += 2) {
            const bool last = (t == nt - 2);
            const char* a1 = cA + (size_t)(t + 1) * kstep;
            const char* a2 = last ? nA : cA + (size_t)(t + 2) * kstep; const char* b2 = last ? nB : cB + (size_t)(t + 2) * kstep;
            const char* a3 = a2 + kstep; const char* b3 = b2 + kstep;
            if (last && has_next) S.a_ready(nxt);
            if constexpr (SP2) {
            PG8_LDB(B0, 0, 0); PG8_LDB(B1, 0, 1); PG8_SCHED; PG8_LDA(At, 0, 0); PG8_STAGE(PG8_SA(1, 1), a1 + hstep, voffA);
            PG8_WAIT_V(8); PG8_WAIT_L(0); PG8_BAR; PG8_MMA(0, 0, At, B0); PG8_MMA(0, 1, At, B1); PG8_BAR; PG8_SCHED;
            PG8_LDA(At, 0, 1); PG8_STAGEB(PG8_SB(0, 0), b2, voffB); PG8_STAGEB(PG8_SB(0, 1), b2 + hstep, voffB); PG8_STAGE(PG8_SA(0, 0), a2, voffA);
            PG8_WAIT_V(8); PG8_WAIT_L(0); PG8_BAR; PG8_MMA(1, 0, At, B0); PG8_MMA(1, 1, At, B1); PG8_BAR; PG8_SCHED;
            PG8_LDB(B0, 1, 0); PG8_LDB(B1, 1, 1); PG8_SCHED; PG8_LDA(At, 1, 0); PG8_STAGE(PG8_SA(0, 1), a2 + hstep, voffA);
            PG8_WAIT_V(8); PG8_WAIT_L(0); PG8_BAR; PG8_MMA(0, 0, At, B0); PG8_MMA(0, 1, At, B1); PG8_BAR; PG8_SCHED;
            PG8_LDA(At, 1, 1); PG8_STAGEB(PG8_SB(1, 0), b3, voffB); PG8_STAGEB(PG8_SB(1, 1), b3 + hstep, voffB); PG8_STAGE(PG8_SA(1, 0), a3, voffA);
            PG8_WAIT_V(8); PG8_WAIT_L(0); PG8_BAR; PG8_MMA(1, 0, At, B0); PG8_MMA(1, 1, At, B1); PG8_BAR; PG8_SCHED;
            } else {
            PG8_LDB(B0, 0, 0); PG8_SCHED; PG8_LDA(At, 0, 0); PG8_STAGE(PG8_SA(1, 1), a1 + hstep, voffA);
            PG8_WAIT_L(8); PG8_BAR; PG8_WAIT_L(0); PG8_MMA(0, 0, At, B0); PG8_BAR; PG8_SCHED;
            PG8_LDB(B1, 0, 1); PG8_STAGEB(PG8_SB(0, 0), b2, voffB);
            PG8_BAR; PG8_WAIT_L(0); PG8_MMA(0, 1, At, B1); PG8_BAR;
            PG8_LDA(At, 0, 1); PG8_STAGE(PG8_SA(0, 0), a2, voffA);
            PG8_BAR; PG8_WAIT_L(0); PG8_MMA(1, 0, At, B0); PG8_BAR; PG8_SCHED;
            PG8_STAGEB(PG8_SB(0, 1), b2 + hstep, voffB);
            PG8_WAIT_V(6); PG8_BAR; PG8_MMA(1, 1, At, B1); PG8_BAR;
            PG8_LDB(B0, 1, 0); PG8_SCHED; PG8_LDA(At, 1, 0); PG8_STAGE(PG8_SA(0, 1), a2 + hstep, voffA);
            PG8_WAIT_L(8); PG8_BAR; PG8_WAIT_L(0); PG8_MMA(0, 0, At, B0); PG8_BAR; PG8_SCHED;
            PG8_LDB(B1, 1, 1); PG8_STAGEB(PG8_SB(1, 0), b3, voffB);
            PG8_BAR; PG8_WAIT_L(0); PG8_MMA(0, 1, At, B1); PG8_BAR;
            PG8_LDA(At, 1, 1); PG8_STAGE(PG8_SA(1, 0), a3, voffA);
            PG8_BAR; PG8_WAIT_L(0); PG8_MMA(1, 0, At, B0); PG8_BAR; PG8_SCHED;
            PG8_STAGEB(PG8_SB(1, 1), b3 + hstep, voffB);
            PG8_WAIT_V(6); PG8_BAR; PG8_MMA(1, 1, At, B1); PG8_BAR;
            }
        }
        if constexpr (ALIGN_EPI) { if (wr == 0) PG8_BAR; }
        if constexpr (!Epi::AFTER_DRAIN) { E(acc, cur, wr, wc, fr, fq); S.done(cur); }
        if (!has_next) break;
#pragma unroll
        for (int a = 0; a < 2; ++a)
#pragma unroll
            for (int b = 0; b < 2; ++b)
#pragma unroll
                for (int m = 0; m < 4; ++m)
#pragma unroll
                    for (int n = 0; n < 2; ++n) acc[a][b][m][n] = (f32x4){0.f, 0.f, 0.f, 0.f};
        cur = nxt; cA = nA; cB = nB; ++ui;
        if constexpr (ALIGN_EPI) { if (wr == 1) PG8_BAR; }
    }
    PG8_WAIT_V(0);
    if constexpr (!ALIGN_EPI) { if (wr == 0) PG8_BAR; }
    PG8_BAR;
    if constexpr (Epi::AFTER_DRAIN) { E.fused(acc, cur, wr, wc, fr, fq, lds, wid, lane); S.done(cur); }
#undef PG8_SA
#undef PG8_SB
#undef PG8_STAGE
#undef PG8_STAGEB
#undef PG8_LDA
#undef PG8_LDB
#undef PG8_MMA
#undef PG8_WAIT_V
#undef PG8_WAIT_L
#undef PG8_BAR
#undef PG8_SCHED
}
}

using pg8::bf16_t; using pg8::bf16x8; using pg8::f32x4; using pg8::u32x4; using pg8::Unit;
#define LAS __attribute__((address_space(3)))
typedef float f32x16 __attribute__((ext_vector_type(16)));
typedef short s16x4 __attribute__((ext_vector_type(4)));
typedef float f32x2_t __attribute__((ext_vector_type(2)));
typedef __bf16 bf16x2_t __attribute__((ext_vector_type(2)));
typedef unsigned u32x2 __attribute__((ext_vector_type(2)));

constexpr int T = 8192, D = 2048, SEQ = 4096, FF = 5632, INC = 5376, MEMT = 512, MEML = 256;
constexpr float EPS = 1e-6f, LOG2E = 1.4426950408889634f;
constexpr int NPH = 14;
#ifndef STG_NT
#define STG_NT 0
#endif
#ifndef WO_IN_P0
#define WO_IN_P0 1
#endif
#ifndef W2GU_SPLIT
#define W2GU_SPLIT 17792
#endif
#ifndef X_LAST
#define X_LAST 0
#endif
#ifndef P2_BASE_F32
#define P2_BASE_F32 true
#endif
#ifndef GEMM_SP2
#define GEMM_SP2 true
#endif
#ifndef GEMM_ALIGN1
#define GEMM_ALIGN1 true
#endif
#ifndef MK_SINGLE
#define MK_SINGLE 1
#endif

constexpr size_t MiB = 1u << 20;
constexpr size_t WS_SSQX = 262144;
constexpr size_t WS_SSQ0 = 0, WS_SSQ1 = 32768, WS_SSQ2 = 65536, WS_SSQ3 = 98304, WS_SSQ4 = 131072, WS_SSQM = 163840;
constexpr size_t WS_CTL = 196608, CTL_BYTES = 32768, WS_XBUF = 524288;
constexpr int LDS_BAR_OFF = 139264;
constexpr size_t WS_C128 = 1 * MiB, WS_S128 = 2 * MiB, WS_C64 = 3 * MiB, WS_S64 = 3 * MiB + 512 * 1024;
constexpr size_t WS_MEMB = 4 * MiB, WS_XK = 6 * MiB, WS_XVT = 8 * MiB;
constexpr size_t WS_W1GU = 16 * MiB, WS_W1D = 60 * MiB, WS_WIN = 82 * MiB, WS_WOUT = 103 * MiB, WS_WQ = 111 * MiB, WS_WKV = 119 * MiB, WS_WO = 135 * MiB,
                 WS_W2GU = 143 * MiB, WS_W2D = 187 * MiB;
constexpr size_t WS_XB = 209 * MiB, WS_MIX = 241 * MiB, WS_R1 = 273 * MiB, WS_VWOT = 409 * MiB, WS_END = 417 * MiB;
constexpr size_t R1_ACT = 0, R1_RQ = 0, R1_RK = 16 * MiB, R1_RV = 32 * MiB, R1_RG = 48 * MiB, R1_SQ = 64 * MiB, R1_SK = 80 * MiB, R1_SV = 82 * MiB,
                 R1_STATE = 84 * MiB, R1_SPREV = 116 * MiB, R1_XQ = 0, R1_XO = 32 * MiB;
constexpr int LDS_BYTES = 147456;

__device__ __forceinline__ unsigned cvtpk(float lo, float hi) { f32x2_t v = {lo, hi}; bf16x2_t b = __builtin_convertvector(v, bf16x2_t); return __builtin_bit_cast(unsigned, b); }
__device__ __forceinline__ float bf2f(unsigned short b) { return __uint_as_float(((unsigned)b) << 16); }
__device__ __forceinline__ float bflo(unsigned w) { return __uint_as_float(w << 16); }
__device__ __forceinline__ float bfhi(unsigned w) { return __uint_as_float(w & 0xffff0000u); }
__device__ __forceinline__ int crow(int r, int hi) { return (r & 3) + 8 * (r >> 2) + 4 * hi; }
__device__ __forceinline__ float silu_f(float g) { return g * __builtin_amdgcn_rcpf(1.0f + __builtin_amdgcn_exp2f(-g * LOG2E)); }
__device__ __forceinline__ float lg2gamma(int h) { return log2f(1.0f - exp2f(-5.0f - (float)h)); }
__device__ __forceinline__ float wave_sum(float v) {
#pragma unroll
    for (int o = 1; o < 64; o <<= 1) v += __shfl_xor(v, o);
    return v;
}
__device__ __forceinline__ bf16x8 pack8(const f32x16& p, int s) {
    u32x4 w; w.x = cvtpk(p[8 * s + 0], p[8 * s + 1]); w.y = cvtpk(p[8 * s + 2], p[8 * s + 3]); w.z = cvtpk(p[8 * s + 4], p[8 * s + 5]); w.w = cvtpk(p[8 * s + 6], p[8 * s + 7]);
    return __builtin_bit_cast(bf16x8, w);
}
__device__ __forceinline__ bf16x8 lds_cat(const LAS bf16_t* p) {
    const s16x4 a = *(const LAS s16x4*)p, b = *(const LAS s16x4*)(p + 8);
    return __builtin_shufflevector(a, b, 0, 1, 2, 3, 4, 5, 6, 7);
}
__device__ __forceinline__ bf16x8 g_cat(const bf16_t* p) {
    const s16x4 a = *(const s16x4*)p, b = *(const s16x4*)(p + 8);
    return __builtin_shufflevector(a, b, 0, 1, 2, 3, 4, 5, 6, 7);
}
#ifndef WT_STORES
#define WT_STORES 0
#endif
#ifndef EPI_NT
#define EPI_NT 0
#endif
#ifndef ACT_NT
#define ACT_NT 0
#endif
__device__ __forceinline__ void st16(void* p, u32x4 v) {
#if WT_STORES
    asm volatile("global_store_dwordx4 %0, %1, off sc0 sc1" :: "v"(p), "v"(v) : "memory");
#elif EPI_NT
    __builtin_nontemporal_store(v, (u32x4*)p);
#else
    *(u32x4*)p = v;
#endif
}
#define MFMA32(a, b, c) __builtin_amdgcn_mfma_f32_32x32x16_bf16((a), (b), (c), 0, 0, 0)

struct EpiSwiGLU {
    static constexpr bool PERM = true, AFTER_DRAIN = false;
    bf16_t* O; const float* ssq;
    __device__ __forceinline__ void operator()(const f32x4 (&acc)[2][2][4][2], const Unit& u, int wr, int wc, int fr, int fq) const {
        const int row0 = u.pm * 256 + wr * 64 + fr, col0 = u.pn * 128 + wc * 32 + 8 * fq;
#pragma unroll
        for (int ai = 0; ai < 2; ++ai)
#pragma unroll
            for (int m = 0; m < 4; ++m) {
                const int row = row0 + ai * 128 + m * 16;
                const float rs = rsqrtf(ssq[row] * (1.0f / D) + EPS);
                const float c1 = -rs * LOG2E, c2 = rs * rs;
                float o[8];
#pragma unroll
                for (int n = 0; n < 2; ++n)
#pragma unroll
                    for (int e = 0; e < 4; e += 2) {
                        const f32x2_t g = {acc[ai][0][m][n][e], acc[ai][0][m][n][e + 1]}, up = {acc[ai][1][m][n][e], acc[ai][1][m][n][e + 1]};
                        const f32x2_t t = g * c1; f32x2_t ex; ex.x = __builtin_amdgcn_exp2f(t.x); ex.y = __builtin_amdgcn_exp2f(t.y);
                        const f32x2_t d = ex + 1.0f; f32x2_t sg; sg.x = __builtin_amdgcn_rcpf(d.x); sg.y = __builtin_amdgcn_rcpf(d.y);
                        const f32x2_t r = (g * up) * (sg * c2);
                        o[4 * n + e] = r.x; o[4 * n + e + 1] = r.y;
                    }
                u32x4 w; w.x = cvtpk(o[0], o[1]); w.y = cvtpk(o[2], o[3]); w.z = cvtpk(o[4], o[5]); w.w = cvtpk(o[6], o[7]);
                if (ACT_NT) __builtin_nontemporal_store(w, (u32x4*)(O + (size_t)row * FF + col0)); else st16(O + (size_t)row * FF + col0, w);
            }
    }
};
template <bool BASE_F32, bool OUT_F32> struct EpiResid {
    static constexpr bool PERM = true, AFTER_DRAIN = false;
    const float* base; float* out; bf16_t* xb; float* ssq_out; float scale;
    __device__ __forceinline__ void operator()(const f32x4 (&acc)[2][2][4][2], const Unit& u, int wr, int wc, int fr, int fq) const {
        const int row0 = u.pm * 256 + wr * 64 + fr, col0 = (u.pn & 7) * 256 + wc * 32 + 8 * fq;
#pragma unroll
        for (int ai = 0; ai < 2; ++ai)
#pragma unroll
            for (int m = 0; m < 4; ++m) {
                const int row = row0 + ai * 128 + m * 16; float s = 0.f;
#pragma unroll
                for (int bj = 0; bj < 2; ++bj) {
                    const size_t off = (size_t)row * D + col0 + bj * 128;
                    f32x4 b0, b1;
                    if (BASE_F32) { b0 = __builtin_nontemporal_load((const f32x4*)(base + off)); b1 = __builtin_nontemporal_load((const f32x4*)(base + off + 4)); }
                    else { const u32x4 w = *(const u32x4*)(xb + off); b0 = (f32x4){bflo(w.x), bfhi(w.x), bflo(w.y), bfhi(w.y)}; b1 = (f32x4){bflo(w.z), bfhi(w.z), bflo(w.w), bfhi(w.w)}; }
                    const f32x4 h0 = b0 + acc[ai][bj][m][0] * scale, h1 = b1 + acc[ai][bj][m][1] * scale;
                    if (OUT_F32) { *(f32x4*)(out + off) = h0; *(f32x4*)(out + off + 4) = h1; }
                    else { u32x4 w; w.x = cvtpk(h0[0], h0[1]); w.y = cvtpk(h0[2], h0[3]); w.z = cvtpk(h1[0], h1[1]); w.w = cvtpk(h1[2], h1[3]); st16(xb + off, w); }
                    s += (h0[0] * h0[0] + h0[1] * h0[1]) + (h0[2] * h0[2] + h0[3] * h0[3]) + (h1[0] * h1[0] + h1[1] * h1[1]) + (h1[2] * h1[2] + h1[3] * h1[3]);
                }
                s += __shfl_xor(s, 16); s += __shfl_xor(s, 32);
                if (fq == 0) __hip_atomic_fetch_add(ssq_out + row, s, __ATOMIC_RELAXED, __HIP_MEMORY_SCOPE_AGENT);
            }
    }
};
struct EpiFinal {
    static constexpr bool PERM = true, AFTER_DRAIN = true;
    float* out; const bf16_t* xb; float* xbuf; unsigned* cnt; const float* gain; float scale;
    __device__ __forceinline__ void fused(f32x4 (&acc)[2][2][4][2], const Unit& u, int wr, int wc, int fr, int fq, PG8_LAS unsigned char* lds, int wid, int lane) const {
        LAS float* P = (LAS float*)lds;
        LAS float* S = (LAS float*)(lds + 4096);
        const int col0 = u.pn * 256 + wc * 32 + 8 * fq;
#pragma unroll
        for (int ai = 0; ai < 2; ++ai)
#pragma unroll
            for (int m = 0; m < 4; ++m) {
                const int rl = ai * 128 + wr * 64 + m * 16 + fr; float s = 0.f;
#pragma unroll
                for (int bj = 0; bj < 2; ++bj) {
                    const size_t off = (size_t)(u.pm * 256 + rl) * D + col0 + bj * 128;
                    const u32x4 w = *(const u32x4*)(xb + off);
                    const f32x4 b0 = (f32x4){bflo(w.x), bfhi(w.x), bflo(w.y), bfhi(w.y)}, b1 = (f32x4){bflo(w.z), bfhi(w.z), bflo(w.w), bfhi(w.w)};
                    const f32x4 h0 = b0 + acc[ai][bj][m][0] * scale, h1 = b1 + acc[ai][bj][m][1] * scale;
                    acc[ai][bj][m][0] = h0; acc[ai][bj][m][1] = h1;
                    s += (h0[0] * h0[0] + h0[1] * h0[1]) + (h0[2] * h0[2] + h0[3] * h0[3]) + (h1[0] * h1[0] + h1[1] * h1[1]) + (h1[2] * h1[2] + h1[3] * h1[3]);
                }
                s += __shfl_xor(s, 16); s += __shfl_xor(s, 32);
                if (fq == 0) P[rl * 4 + wc] = s;
            }
        asm volatile("s_waitcnt lgkmcnt(0)" ::: "memory"); __builtin_amdgcn_s_barrier(); asm volatile("" ::: "memory");
        const int row = wid * 32 + (lane & 31);
        if (lane < 32) {
            const float t = (P[row * 4 + 0] + P[row * 4 + 1]) + (P[row * 4 + 2] + P[row * 4 + 3]);
            __hip_atomic_store(xbuf + (size_t)(u.pm * 256 + row) * 8 + u.pn, t, __ATOMIC_RELAXED, __HIP_MEMORY_SCOPE_AGENT);
        }
        asm volatile("s_waitcnt vmcnt(0)" ::: "memory");
        unsigned* c = cnt + 64 * u.pm;
        if (lane == 0) __hip_atomic_fetch_add(c, 1u, __ATOMIC_RELAXED, __HIP_MEMORY_SCOPE_AGENT);
        if (wid == 0) {
            unsigned sp = 0;
            while ((unsigned)__builtin_amdgcn_readfirstlane(__hip_atomic_load(c, __ATOMIC_RELAXED, __HIP_MEMORY_SCOPE_AGENT)) < 64u) { __builtin_amdgcn_s_sleep(2); if (++sp > (1u << 22)) break; }
            __builtin_amdgcn_fence(__ATOMIC_ACQUIRE, "agent");
        }
        asm volatile("s_waitcnt vmcnt(0) lgkmcnt(0)" ::: "memory"); __builtin_amdgcn_s_barrier(); asm volatile("" ::: "memory");
        if (lane < 32) {
            const float* slot = xbuf + (size_t)(u.pm * 256 + row) * 8; float t = 0.f;
#pragma unroll
            for (int k = 0; k < 8; ++k) t += __hip_atomic_load(slot + k, __ATOMIC_RELAXED, __HIP_MEMORY_SCOPE_AGENT);
            S[row] = rsqrtf(t * (1.0f / D) + EPS);
        }
        asm volatile("s_waitcnt vmcnt(0) lgkmcnt(0)" ::: "memory"); __builtin_amdgcn_s_barrier(); asm volatile("" ::: "memory");
        f32x4 g[2][2];
#pragma unroll
        for (int bj = 0; bj < 2; ++bj) { g[bj][0] = *(const f32x4*)(gain + col0 + bj * 128); g[bj][1] = *(const f32x4*)(gain + col0 + bj * 128 + 4); }
#pragma unroll
        for (int ai = 0; ai < 2; ++ai)
#pragma unroll
            for (int m = 0; m < 4; ++m) {
                const int rl = ai * 128 + wr * 64 + m * 16 + fr; const float rs = S[rl];
#pragma unroll
                for (int bj = 0; bj < 2; ++bj) {
                    const size_t off = (size_t)(u.pm * 256 + rl) * D + col0 + bj * 128;
                    *(f32x4*)(out + off) = acc[ai][bj][m][0] * rs * g[bj][0]; *(f32x4*)(out + off + 4) = acc[ai][bj][m][1] * rs * g[bj][1];
                }
            }
    }
};
struct EpiVWo {
    static constexpr bool PERM = true, AFTER_DRAIN = false;
    bf16_t* VWOT;
    __device__ __forceinline__ void operator()(const f32x4 (&acc)[2][2][4][2], const Unit& u, int wr, int wc, int fr, int fq) const {
        const int row0 = u.pm * 256 + wr * 64 + fr, col0 = u.pn * 256 + wc * 32 + 8 * fq;
#pragma unroll
        for (int ai = 0; ai < 2; ++ai)
#pragma unroll
            for (int m = 0; m < 4; ++m) {
                const int row = row0 + ai * 128 + m * 16, n = row & 2047;
#pragma unroll
                for (int bj = 0; bj < 2; ++bj) {
                    const int c = col0 + bj * 128, b = c >> 10, hm = c & 1023;
                    const f32x4 v0 = acc[ai][bj][m][0], v1 = acc[ai][bj][m][1];
                    u32x4 w; w.x = cvtpk(v0[0], v0[1]); w.y = cvtpk(v0[2], v0[3]); w.z = cvtpk(v1[0], v1[1]); w.w = cvtpk(v1[2], v1[3]);
                    *(u32x4*)(VWOT + ((size_t)(b * 2048 + n)) * 1024 + hm) = w;
                }
            }
    }
};
struct VwoOrder {
    int idx;
    __device__ __forceinline__ bool next(int i, Unit& u) const { if (i != 0 || idx < 0 || idx >= 64) return false; const int h = idx >> 4, b = (idx >> 3) & 1; u.pm = h * 8 + (idx & 7); u.pn = b * 4 + h; return true; }
    __device__ __forceinline__ void a_ready(const Unit&) const {}
    __device__ __forceinline__ void done(const Unit&) const {}
};
struct OutOrder {
    pg8::StaticOrder b;
    __device__ __forceinline__ bool next(int i, Unit& u) const { if (!b.next(i, u)) return false; u.pn += 8 * (u.pm >> 4); return true; }
    __device__ __forceinline__ void a_ready(const Unit&) const {}
    __device__ __forceinline__ void done(const Unit&) const {}
};
struct EpiScale {
    static constexpr bool PERM = true, AFTER_DRAIN = false;
    bf16_t* O; const float* ssq; float cs;
    __device__ __forceinline__ void operator()(const f32x4 (&acc)[2][2][4][2], const Unit& u, int wr, int wc, int fr, int fq) const {
        const int row0 = u.pm * 256 + wr * 64 + fr, col0 = u.pn * 256 + wc * 32 + 8 * fq;
#pragma unroll
        for (int ai = 0; ai < 2; ++ai)
#pragma unroll
            for (int m = 0; m < 4; ++m) {
                const int row = row0 + ai * 128 + m * 16;
                const float rs = rsqrtf(ssq[row] * (1.0f / D) + EPS) * cs;
#pragma unroll
                for (int bj = 0; bj < 2; ++bj) {
                    const f32x4 v0 = acc[ai][bj][m][0] * rs, v1 = acc[ai][bj][m][1] * rs;
                    u32x4 w; w.x = cvtpk(v0[0], v0[1]); w.y = cvtpk(v0[2], v0[3]); w.z = cvtpk(v1[0], v1[1]); w.w = cvtpk(v1[2], v1[3]);
                    st16(O + (size_t)row * D + col0 + bj * 128, w);
                }
            }
    }
};
struct EpiKV {
    static constexpr bool PERM = true, AFTER_DRAIN = false;
    bf16_t* XK; bf16_t* XVT; const float* ssq;
    __device__ __forceinline__ void operator()(const f32x4 (&acc)[2][2][4][2], const Unit& u, int wr, int wc, int fr, int fq) const {
        const int row0 = u.pm * 256 + wr * 64 + fr, col0 = u.pn * 256 + wc * 32 + 8 * fq;
#pragma unroll
        for (int ai = 0; ai < 2; ++ai)
#pragma unroll
            for (int m = 0; m < 4; ++m) {
                const int row = row0 + ai * 128 + m * 16;
                const float rs = rsqrtf(ssq[row] * (1.0f / D) + EPS);
#pragma unroll
                for (int bj = 0; bj < 2; ++bj) {
                    const f32x4 v0 = acc[ai][bj][m][0] * rs, v1 = acc[ai][bj][m][1] * rs;
                    const int c = col0 + bj * 128;
                    if (u.pn < 8) {
                        u32x4 w; w.x = cvtpk(v0[0], v0[1]); w.y = cvtpk(v0[2], v0[3]); w.z = cvtpk(v1[0], v1[1]); w.w = cvtpk(v1[2], v1[3]);
                        *(u32x4*)(XK + (size_t)row * D + c) = w;
                    } else {
                        const int cv = c - D;
                        u32x4 w; w.x = cvtpk(v0[0], v0[1]); w.y = cvtpk(v0[2], v0[3]); w.z = cvtpk(v1[0], v1[1]); w.w = cvtpk(v1[2], v1[3]);
                        *(u32x4*)(XVT + ((size_t)(((row >> 8) * 4 + (cv >> 9)) * MEML + (row & 255))) * 512 + (cv & 511)) = w;
                    }
                }
            }
    }
};
struct EpiWin {
    static constexpr bool PERM = true, AFTER_DRAIN = false;
    const float* ssq; bf16_t *RQ, *RK, *RV, *RG, *SQ, *SK, *SV; const float *C128, *S128, *C64, *S64;
    __device__ __forceinline__ void operator()(const f32x4 (&acc)[2][2][4][2], const Unit& u, int wr, int wc, int fr, int fq) const {
        const int row0 = u.pm * 256 + wr * 64 + fr, pn = u.pn;
#pragma unroll
        for (int ai = 0; ai < 2; ++ai)
#pragma unroll
            for (int m = 0; m < 4; ++m) {
                const int row = row0 + ai * 128 + m * 16, pos = row & (SEQ - 1), cp = row & 127;
                const float rs = rsqrtf(ssq[row] * (1.0f / D) + EPS);
                float a[8], b[8];
#pragma unroll
                for (int n = 0; n < 2; ++n)
#pragma unroll
                    for (int e = 0; e < 4; ++e) { a[4 * n + e] = acc[ai][0][m][n][e] * rs; b[4 * n + e] = acc[ai][1][m][n][e] * rs; }
                const bool rope128 = pn < 8, rope64 = (pn >= 16 && pn < 20) || (pn == 20 && wc < 2);
                if (rope128 || rope64) {
                    float cs[8], sn[8]; float sc; bf16_t* dst; int half;
                    if (rope128) {
                        const int sec = pn >> 2, h = 2 * (pn & 3) + (wc >> 1), i0 = (wc & 1) * 32 + 8 * fq;
                        const f32x4 c0 = *(const f32x4*)(C128 + pos * 64 + i0), c1 = *(const f32x4*)(C128 + pos * 64 + i0 + 4);
                        const f32x4 s0 = *(const f32x4*)(S128 + pos * 64 + i0), s1 = *(const f32x4*)(S128 + pos * 64 + i0 + 4);
#pragma unroll
                        for (int e = 0; e < 4; ++e) { cs[e] = c0[e]; cs[4 + e] = c1[e]; sn[e] = s0[e]; sn[4 + e] = s1[e]; }
                        const float lg = lg2gamma(h);
                        sc = sec == 0 ? exp2f((float)cp * lg) : exp2f(-(float)cp * lg) * 0.08838834764831845f;
                        dst = (sec == 0 ? RQ : RK) + (size_t)row * 1024 + h * 128 + i0; half = 64;
                    } else {
                        const int i0 = 8 * fq;
                        const f32x4 c0 = *(const f32x4*)(C64 + pos * 32 + i0), c1 = *(const f32x4*)(C64 + pos * 32 + i0 + 4);
                        const f32x4 s0 = *(const f32x4*)(S64 + pos * 32 + i0), s1 = *(const f32x4*)(S64 + pos * 32 + i0 + 4);
#pragma unroll
                        for (int e = 0; e < 4; ++e) { cs[e] = c0[e]; cs[4 + e] = c1[e]; sn[e] = s0[e]; sn[4 + e] = s1[e]; }
                        if (pn < 20) { sc = 0.125f * LOG2E; dst = SQ + (size_t)row * 1024 + (4 * (pn - 16) + wc) * 64 + i0; }
                        else { sc = 1.0f; dst = SK + (size_t)row * 128 + wc * 64 + i0; }
                        half = 32;
                    }
                    float x1[8], x2[8];
#pragma unroll
                    for (int e = 0; e < 8; ++e) { x1[e] = (a[e] * cs[e] - b[e] * sn[e]) * sc; x2[e] = (b[e] * cs[e] + a[e] * sn[e]) * sc; }
                    u32x4 w1, w2;
                    w1.x = cvtpk(x1[0], x1[1]); w1.y = cvtpk(x1[2], x1[3]); w1.z = cvtpk(x1[4], x1[5]); w1.w = cvtpk(x1[6], x1[7]);
                    w2.x = cvtpk(x2[0], x2[1]); w2.y = cvtpk(x2[2], x2[3]); w2.z = cvtpk(x2[4], x2[5]); w2.w = cvtpk(x2[6], x2[7]);
                    st16(dst, w1); st16(dst + half, w2);
                } else {
                    bf16_t *d0, *d1;
                    if (pn < 12) { d0 = RV + (size_t)row * 1024 + (pn - 8) * 256 + wc * 32 + 8 * fq; d1 = d0 + 128; }
                    else if (pn < 16) {
                        d0 = RG + (size_t)row * 1024 + (pn - 12) * 256 + wc * 32 + 8 * fq; d1 = d0 + 128;
#pragma unroll
                        for (int e = 0; e < 8; ++e) { a[e] = silu_f(a[e]); b[e] = silu_f(b[e]); }
                    } else { d0 = SV + (size_t)row * 128 + (wc - 2) * 32 + 8 * fq; d1 = d0 + 64; }
                    u32x4 w1, w2;
                    w1.x = cvtpk(a[0], a[1]); w1.y = cvtpk(a[2], a[3]); w1.z = cvtpk(a[4], a[5]); w1.w = cvtpk(a[6], a[7]);
                    w2.x = cvtpk(b[0], b[1]); w2.y = cvtpk(b[2], b[3]); w2.z = cvtpk(b[4], b[5]); w2.w = cvtpk(b[6], b[7]);
                    st16(d0, w1); st16(d1, w2);
                }
            }
    }
};

__device__ __forceinline__ int win_src(int d) {
    const int pn = d >> 8, bj = (d >> 7) & 1, o = d & 127;
    if (pn < 8) { const int sec = pn >> 2, pl = pn & 3; return sec * 1024 + (2 * pl + (o >> 6)) * 128 + bj * 64 + (o & 63); }
    if (pn < 16) return d;
    if (pn < 20) { const int pl = pn - 16; return 4096 + (4 * pl + (o >> 5)) * 64 + bj * 32 + (o & 31); }
    if (o < 64) return 5120 + (o >> 5) * 64 + bj * 32 + (o & 31);
    return 5248 + bj * 64 + (o - 64);
}
#ifndef TR_NT
#define TR_NT 1
#endif
#ifndef TR_NTS
#define TR_NTS 1
#endif
#if TR_NT
#define TR_LOAD(p) __builtin_nontemporal_load(p)
#else
#define TR_LOAD(p) (*(p))
#endif
constexpr int TR_NIT = 5632 + 2816 + 2688 + 1024 + 1024 + 2048 + 1024 + 5632 + 2816;
struct TrItem { const float* src; const float* gain; bf16_t* dst; int N, K; bool nts; };
__device__ __forceinline__ TrItem tr_decode(int it, const float* const* in, unsigned char* ws, int lane) {
    int r = it, kind = 0, ndb = 32, N = D, K = D; const float *W, *W2 = nullptr, *gain = nullptr; bf16_t* WT; bool nts = false, woh = false;
    if (r < 5632) { kind = 1; W = in[3]; W2 = in[4]; N = FF; ndb = 176; gain = in[2]; WT = (bf16_t*)(ws + WS_W1GU); }
    else if ((r -= 5632) < 2816) { W = in[5]; K = FF; WT = (bf16_t*)(ws + WS_W1D); }
    else if ((r -= 2816) < 2688) { kind = 2; W = in[7]; N = INC; ndb = 84; gain = in[6]; WT = (bf16_t*)(ws + WS_WIN); nts = true; }
    else if ((r -= 2688) < 1024) { W = in[10]; WT = (bf16_t*)(ws + WS_WOUT); nts = true; }
    else if ((r -= 1024) < 1024) { W = in[13]; gain = in[11]; WT = (bf16_t*)(ws + WS_WQ); nts = true; }
    else if ((r -= 1024) < 2048) { W = in[14]; N = 2 * D; ndb = 64; gain = in[12]; WT = (bf16_t*)(ws + WS_WKV); }
    else if ((r -= 2048) < 1024) { W = in[15]; WT = (bf16_t*)(ws + WS_WO); nts = true; woh = true; }
    else if ((r -= 1024) < 5632) { kind = 1; W = in[17]; W2 = in[18]; N = FF; ndb = 176; gain = in[16]; WT = (bf16_t*)(ws + WS_W2GU); nts = true; }
    else { r -= 5632; W = in[19]; K = FF; WT = (bf16_t*)(ws + WS_W2D); }
#ifndef TR_ORDER
#define TR_ORDER 1
#endif
#if TR_ORDER >= 1
    constexpr int KL = TR_ORDER, DL = 3 - TR_ORDER;
    const int rh = r >> 3, rl = r & 7, nq = ndb >> DL, kbh = rh / nq, dbh = rh - kbh * nq;
    const int kb = (kbh << KL) + (rl >> DL), db = (dbh << DL) + (rl & ((1 << DL) - 1)), d0 = db * 64, k0 = kb * 64;
#else
    const int kb = r / ndb, db = r - kb * ndb, d0 = db * 64, k0 = kb * 64;
#endif
    const int blk = d0 + 32 * ((lane & 15) >> 3);
    const float* src = W; int s0 = blk;
    if (kind == 1) { const int pn = blk >> 8, bj = (blk >> 7) & 1, o = blk & 127; src = bj ? W2 : W; s0 = pn * 128 + o; }
    else if (kind == 2) s0 = win_src(blk);
    TrItem t; t.src = src + (size_t)(k0 + (lane >> 4)) * N + s0 + 4 * (lane & 7); t.gain = gain ? gain + k0 + 8 * (lane & 7) : nullptr;
    t.dst = WT + (size_t)(d0 + (lane >> 3)) * K + k0 + 8 * (lane & 7); t.N = N; t.K = K; t.nts = nts && TR_NTS;
    if (woh) { t.dst = WT + ((size_t)((k0 >> 9) * 2048 + d0 + (lane >> 3))) * 512 + (k0 & 511) + 8 * (lane & 7); t.K = 512; }
    return t;
}
struct TrRanges { int b0, e0, b1, e1, b2, e2;
    __device__ __forceinline__ int count() const { return (e0 - b0) + (e1 - b1) + (e2 - b2); }
    __device__ __forceinline__ int item(int v) const { const int l0 = e0 - b0, l1 = e1 - b1; return v < l0 ? b0 + v : (v < l0 + l1 ? b1 + (v - l0) : b2 + (v - l0 - l1)); } };
__device__ __forceinline__ void tr_all(const float* const* in, unsigned char* ws, LAS float* scr, int gw, int ngw, int lane, const TrRanges rg) {
    const int TR_CNT = rg.count();
    if (gw >= TR_CNT) return;
    TrItem cur = tr_decode(rg.item(gw), in, ws, lane);
    f32x4 v[16];
#pragma unroll
    for (int i = 0; i < 16; ++i) v[i] = TR_LOAD((const f32x4*)(cur.src + (size_t)(4 * i) * cur.N));
    for (int it = gw; it < TR_CNT; it += ngw) {
        const int nit = it + ngw; const bool hn = nit < TR_CNT;
        TrItem nx = cur; f32x4 w[16];
        if (hn) { nx = tr_decode(rg.item(nit), in, ws, lane);
#pragma unroll
            for (int i = 0; i < 16; ++i) w[i] = TR_LOAD((const f32x4*)(nx.src + (size_t)(4 * i) * nx.N)); }
        LAS float* wp = scr + (lane >> 4) * 65 + 4 * (lane & 15);
#pragma unroll
        for (int i = 0; i < 16; ++i) { wp[(4 * i) * 65 + 0] = v[i][0]; wp[(4 * i) * 65 + 1] = v[i][1]; wp[(4 * i) * 65 + 2] = v[i][2]; wp[(4 * i) * 65 + 3] = v[i][3]; }
        f32x4 g0 = {1.f, 1.f, 1.f, 1.f}, g1 = {1.f, 1.f, 1.f, 1.f};
        if (cur.gain) { g0 = *(const f32x4*)cur.gain; g1 = *(const f32x4*)(cur.gain + 4); }
        asm volatile("s_waitcnt lgkmcnt(0)" ::: "memory");
        const LAS float* rp = scr + (8 * (lane & 7)) * 65 + (lane >> 3);
#pragma unroll
        for (int j = 0; j < 8; ++j) { const LAS float* s = rp + 8 * j;
            u32x4 o; o.x = cvtpk(s[0 * 65] * g0[0], s[1 * 65] * g0[1]); o.y = cvtpk(s[2 * 65] * g0[2], s[3 * 65] * g0[3]);
            o.z = cvtpk(s[4 * 65] * g1[0], s[5 * 65] * g1[1]); o.w = cvtpk(s[6 * 65] * g1[2], s[7 * 65] * g1[3]);
            if (cur.nts) __builtin_nontemporal_store(o, (u32x4*)(cur.dst + (size_t)(8 * j) * cur.K)); else *(u32x4*)(cur.dst + (size_t)(8 * j) * cur.K) = o; }
        asm volatile("s_waitcnt lgkmcnt(0)" ::: "memory");
        if (hn) {
#pragma unroll
            for (int i = 0; i < 16; ++i) v[i] = w[i];
            cur = nx; }
    }
}
__device__ __forceinline__ void row_to_bf16(const float* xrow, bf16_t* orow, float* ssq, int lane) {
    float s = 0.f;
#pragma unroll
    for (int j = 0; j < 8; ++j) { const f32x4 v = *((const f32x4*)xrow + lane + 64 * j); s += (v[0] * v[0] + v[1] * v[1]) + (v[2] * v[2] + v[3] * v[3]);
        u32x2 w; w.x = cvtpk(v[0], v[1]); w.y = cvtpk(v[2], v[3]); *((u32x2*)orow + lane + 64 * j) = w; }
    s = wave_sum(s);
    if (lane == 0) *ssq = s;
}

template <int NR>
__device__ __forceinline__ void rows_to_bf16(const float* x, bf16_t* xb, float* ssq, int r, int stride, int nrows, int lane) {
    f32x4 v[NR][8];
#pragma unroll
    for (int k = 0; k < NR; ++k) { const int rr = r + k * stride; if (rr < nrows) {
#pragma unroll
        for (int j = 0; j < 8; ++j) v[k][j] = __builtin_nontemporal_load((const f32x4*)(x + (size_t)rr * D) + lane + 64 * j); } }
#pragma unroll
    for (int k = 0; k < NR; ++k) { const int rr = r + k * stride; if (rr < nrows) {
        float s = 0.f;
#pragma unroll
        for (int j = 0; j < 8; ++j) { const f32x4 t = v[k][j]; s += (t[0] * t[0] + t[1] * t[1]) + (t[2] * t[2] + t[3] * t[3]);
            u32x2 w; w.x = cvtpk(t[0], t[1]); w.y = cvtpk(t[2], t[3]); *((u32x2*)(xb + (size_t)rr * D) + lane + 64 * j) = w; }
        s = wave_sum(s);
        if (lane == 0) ssq[rr] = s; } }
}

__device__ __forceinline__ int swzc(int c, int j) { return j ^ (((c >> 3) & 15) << 3); }
template <int NROWS, int NCOLS, int VS>
__device__ __forceinline__ void stage_T(LAS bf16_t* dstT, const bf16_t* src, long r0, int ld, int col0, long rmin, int tid) {
    constexpr int NCH = NCOLS / 8, TOT = NROWS * NCH;
#pragma unroll
    for (int i = 0; i < TOT / 512; ++i) {
        const int idx = tid + 512 * i;
        int ch, j;
        if (NCH == 16) { ch = (idx & 7) + 8 * ((idx >> 6) & 1); j = ((idx >> 3) & 7) + 8 * (idx >> 7); } else { ch = idx & 7; j = idx >> 3; }
        const long r = r0 + j;
        u32x4 v = {0u, 0u, 0u, 0u};
        if (r >= rmin) v = STG_NT ? __builtin_nontemporal_load((const u32x4*)(src + r * ld + col0 + 8 * ch)) : *(const u32x4*)(src + r * ld + col0 + 8 * ch);
        LAS bf16_t* d = dstT + (8 * ch) * VS + (j ^ ((ch & 15) << 3));
        d[0 * VS] = (bf16_t)(v.x & 0xffffu); d[1 * VS] = (bf16_t)(v.x >> 16); d[2 * VS] = (bf16_t)(v.y & 0xffffu); d[3 * VS] = (bf16_t)(v.y >> 16);
        d[4 * VS] = (bf16_t)(v.z & 0xffffu); d[5 * VS] = (bf16_t)(v.z >> 16); d[6 * VS] = (bf16_t)(v.w & 0xffffu); d[7 * VS] = (bf16_t)(v.w >> 16);
    }
}
template <int VS>
__device__ __forceinline__ bf16x8 lds_cat_sw(const LAS bf16_t* base, int dd, int c0) {
    const LAS bf16_t* rp = base + dd * VS;
    const s16x4 a = *(const LAS s16x4*)(rp + swzc(dd, c0)), b = *(const LAS s16x4*)(rp + swzc(dd, c0 + 8));
    return __builtin_shufflevector(a, b, 0, 1, 2, 3, 4, 5, 6, 7);
}

__device__ __forceinline__ void swa_item(int it, LAS unsigned char* lds, const bf16_t* SQ, const bf16_t* SK, const bf16_t* SV, const float* sinks, bf16_t* MIX, int tid, int wid, int lane) {
    const int hh = it & 1, kvh = (it >> 1) & 1, n = (it >> 2) & 31, b = it >> 7;
    constexpr int VS = 264;
    LAS bf16_t* VT = (LAS bf16_t*)lds;
    const long rb = (long)b * SEQ; const int pos0 = n * 128;
    __syncthreads();
    stage_T<256, 64, VS>(VT, SV, rb + pos0 - 128, 128, kvh * 64, rb, tid);
    __syncthreads();
    const int x = lane & 31, hi = lane >> 5;
#pragma unroll 1
    for (int tk = wid; tk < 16; tk += 8) {
        const int hl = tk >> 2, qt = tk & 3, head = kvh * 8 + hh * 4 + hl;
        const long qrow = rb + pos0 + 32 * qt + x;
        bf16x8 qf[4];
#pragma unroll
        for (int ks = 0; ks < 4; ++ks) qf[ks] = *(const bf16x8*)(SQ + qrow * 1024 + head * 64 + 16 * ks + 8 * hi);
        f32x16 st[5];
#pragma unroll
        for (int t = 0; t < 5; ++t) {
            int kp = pos0 + 32 * qt - 128 + 32 * t + x; if (kp < 0) kp = 0;
            const bf16_t* kptr = SK + (rb + kp) * 128 + kvh * 64 + 8 * hi;
            f32x16 acc = {};
#pragma unroll
            for (int ks = 0; ks < 4; ++ks) acc = MFMA32(*(const bf16x8*)(kptr + 16 * ks), qf[ks], acc);
            st[t] = acc;
        }
        const float sink2 = sinks[head] * LOG2E;
        float mx = sink2;
#pragma unroll
        for (int r = 0; r < 16; ++r) { const int kk = crow(r, hi); if (kk <= x || (n == 0)) st[0][r] = -1e30f; if (kk > x) st[4][r] = -1e30f; }
#pragma unroll
        for (int t = 1; t < 4; ++t) if (n == 0 && qt + t < 4) {
#pragma unroll
            for (int r = 0; r < 16; ++r) st[t][r] = -1e30f; }
#pragma unroll
        for (int t = 0; t < 5; ++t)
#pragma unroll
            for (int r = 0; r < 16; ++r) mx = fmaxf(mx, st[t][r]);
        mx = fmaxf(mx, __shfl_xor(mx, 32));
        float sum = 0.f;
#pragma unroll
        for (int t = 0; t < 5; ++t)
#pragma unroll
            for (int r = 0; r < 16; ++r) { const float p = __builtin_amdgcn_exp2f(st[t][r] - mx); st[t][r] = p; sum += p; }
        sum += __shfl_xor(sum, 32); sum += __builtin_amdgcn_exp2f(sink2 - mx);
        const float inv = 1.0f / sum;
        f32x16 o0 = {}, o1 = {};
#pragma unroll
        for (int t = 0; t < 5; ++t)
#pragma unroll
            for (int s = 0; s < 2; ++s) {
                const bf16x8 pb = pack8(st[t], s);
                const int c0 = 32 * (qt + t) + 16 * s + 4 * hi;
                o0 = MFMA32(lds_cat_sw<VS>(VT, x, c0), pb, o0); o1 = MFMA32(lds_cat_sw<VS>(VT, 32 + x, c0), pb, o1);
                __builtin_amdgcn_sched_barrier(0);
            }
        bf16_t* op = MIX + qrow * 2048 + 1024 + head * 64 + 4 * hi;
#pragma unroll
        for (int g = 0; g < 4; ++g) {
            u32x2 w0, w1; w0.x = cvtpk(o0[4 * g] * inv, o0[4 * g + 1] * inv); w0.y = cvtpk(o0[4 * g + 2] * inv, o0[4 * g + 3] * inv);
            w1.x = cvtpk(o1[4 * g] * inv, o1[4 * g + 1] * inv); w1.y = cvtpk(o1[4 * g + 2] * inv, o1[4 * g + 3] * inv);
            *(u32x2*)(op + 8 * g) = w0; *(u32x2*)(op + 32 + 8 * g) = w1;
        }
    }
}

__device__ __forceinline__ void kv_item2(int it0, LAS unsigned char* lds, const bf16_t* RK, const bf16_t* RV, float* STATE, int tid, int wid, int lane) {
    constexpr int VS = 136, TILE = 128 * VS;
    LAS bf16_t* L = (LAS bf16_t*)lds;
    __syncthreads();
#pragma unroll
    for (int k = 0; k < 2; ++k) {
        const int it = it0 + k, bh = it >> 5, n = it & 31, b = bh >> 3, h = bh & 7; const long r0 = (long)b * SEQ + n * 128;
        stage_T<128, 128, VS>(L + (2 * k) * TILE, RK, r0, 1024, h * 128, 0, tid);
        stage_T<128, 128, VS>(L + (2 * k + 1) * TILE, RV, r0, 1024, h * 128, 0, tid);
    }
    __syncthreads();
    const int half = wid >> 2, it = it0 + half, h = (it >> 5) & 7;
    const LAS bf16_t* KT = L + (2 * half) * TILE; const LAS bf16_t* VT = KT + TILE;
    const int x = lane & 31, hi = lane >> 5, et = wid & 3;
    f32x16 acc[4];
#pragma unroll
    for (int dt = 0; dt < 4; ++dt) acc[dt] = f32x16{};
#pragma unroll
    for (int ks = 0; ks < 8; ++ks) {
        const int ea = 32 * et + x, cc = 16 * ks + 8 * hi;
        const bf16x8 A = *(const LAS bf16x8*)(VT + ea * VS + swzc(ea, cc));
#pragma unroll
        for (int dt = 0; dt < 4; ++dt) { const int da = 32 * dt + x; acc[dt] = MFMA32(A, *(const LAS bf16x8*)(KT + da * VS + swzc(da, cc)), acc[dt]); }
    }
    const float g127 = exp2f(127.0f * lg2gamma(h));
    float* sp = STATE + (size_t)it * 16384;
#pragma unroll
    for (int dt = 0; dt < 4; ++dt)
#pragma unroll
        for (int r = 0; r < 16; ++r) sp[(32 * et + crow(r, hi)) * 128 + 32 * dt + x] = acc[dt][r] * g127;
}

__device__ __forceinline__ void ro_item2(int it0, LAS unsigned char* lds, const bf16_t* RQ, const bf16_t* RK, const bf16_t* RV, const bf16_t* RG, const bf16_t* SPREV, const float* GN, bf16_t* MIX,
                                         int tid, int wid, int lane) {
    constexpr int VS = 136, TILE = 128 * VS;
    LAS bf16_t* L = (LAS bf16_t*)lds;
    __syncthreads();
#pragma unroll
    for (int k = 0; k < 2; ++k) {
        const int it = it0 + k, bh = it >> 5, n = it & 31, b = bh >> 3, h = bh & 7;
        stage_T<128, 128, VS>(L + k * TILE, RV, (long)b * SEQ + n * 128, 1024, h * 128, 0, tid);
    }
    __syncthreads();
    const int half = wid >> 2, it = it0 + half, bh = it >> 5, n = it & 31, b = bh >> 3, h = bh & 7;
    const LAS bf16_t* VT = L + half * TILE;
    const long r0 = (long)b * SEQ + n * 128;
    const int x = lane & 31, hi = lane >> 5, ct = wid & 3;
    const long qrow = r0 + 32 * ct + x;
    bf16x8 qf[8];
#pragma unroll
    for (int ks = 0; ks < 8; ++ks) qf[ks] = *(const bf16x8*)(RQ + qrow * 1024 + h * 128 + 16 * ks + 8 * hi);
    f32x16 o[4];
#pragma unroll
    for (int et = 0; et < 4; ++et) o[et] = f32x16{};
    for (int jt = 0; jt <= ct; ++jt) {
        f32x16 st = {};
        const bf16_t* kptr = RK + (r0 + 32 * jt + x) * 1024 + h * 128 + 8 * hi;
#pragma unroll
        for (int ks = 0; ks < 8; ++ks) st = MFMA32(*(const bf16x8*)(kptr + 16 * ks), qf[ks], st);
        if (jt == ct) {
#pragma unroll
            for (int r = 0; r < 16; ++r) if (crow(r, hi) > x) st[r] = 0.f;
        }
#pragma unroll
        for (int s2 = 0; s2 < 2; ++s2) {
            const bf16x8 pb = pack8(st, s2);
#pragma unroll
            for (int et = 0; et < 4; ++et) o[et] = MFMA32(lds_cat_sw<VS>(VT, 32 * et + x, 32 * jt + 16 * s2 + 4 * hi), pb, o[et]);
        }
    }
    const bf16_t* sp = SPREV + (size_t)it * 16384;
#pragma unroll
    for (int et = 0; et < 4; ++et)
#pragma unroll
        for (int ks = 0; ks < 8; ++ks) o[et] = MFMA32(*(const bf16x8*)(sp + (32 * et + x) * 128 + 16 * ks + 8 * hi), qf[ks], o[et]);
    float s1 = 0.f, s2 = 0.f;
#pragma unroll
    for (int et = 0; et < 4; ++et)
#pragma unroll
        for (int r = 0; r < 16; ++r) { s1 += o[et][r]; s2 += o[et][r] * o[et][r]; }
    s1 += __shfl_xor(s1, 32); s2 += __shfl_xor(s2, 32);
    const float mean = s1 * (1.0f / 128.0f), var = fmaxf(s2 * (1.0f / 128.0f) - mean * mean, 0.f), rstd = rsqrtf(var + EPS);
#pragma unroll
    for (int et = 0; et < 4; ++et)
#pragma unroll
        for (int g = 0; g < 4; ++g) {
            const int e0 = 32 * et + 8 * g + 4 * hi;
            const u32x2 gt = *(const u32x2*)(RG + qrow * 1024 + h * 128 + e0);
            const f32x4 gn = *(const f32x4*)(GN + h * 128 + e0);
            const float y0 = (o[et][4 * g] - mean) * rstd * gn[0] * bflo(gt.x), y1 = (o[et][4 * g + 1] - mean) * rstd * gn[1] * bfhi(gt.x);
            const float y2 = (o[et][4 * g + 2] - mean) * rstd * gn[2] * bflo(gt.y), y3 = (o[et][4 * g + 3] - mean) * rstd * gn[3] * bfhi(gt.y);
            u32x2 w; w.x = cvtpk(y0, y1); w.y = cvtpk(y2, y3);
            *(u32x2*)(MIX + qrow * 2048 + h * 128 + e0) = w;
        }
}

__device__ __forceinline__ void xa_item(int it, LAS unsigned char* lds, const bf16_t* XQ, const bf16_t* XK, bf16_t* PB, int tid, int wid, int lane) {
    const int qb = it & 31, head = (it >> 5) & 3, b = it >> 7;
    const int x = lane & 31, hi = lane >> 5;
    constexpr int KS = 136;
    LAS bf16_t* KL = (LAS bf16_t*)lds;
    const long qrow = (long)b * SEQ + qb * 128 + 32 * (wid & 3) + x;
    const bf16_t* qp = XQ + qrow * 2048 + head * 512 + 8 * hi;
    const bf16_t* ksrc = XK + (size_t)(b * MEML + (tid >> 4)) * 2048 + head * 512 + 8 * (tid & 15);
    u32x4 R[8];
#pragma unroll
    for (int i = 0; i < 8; ++i) R[i] = *(const u32x4*)(ksrc + (size_t)(32 * i) * 2048);
    f32x16 st[8];
#pragma unroll
    for (int mt = 0; mt < 8; ++mt) st[mt] = f32x16{};
#pragma unroll 1
    for (int c = 0; c < 4; ++c) {
        __syncthreads();
#pragma unroll
        for (int i = 0; i < 8; ++i) *(LAS u32x4*)(KL + ((tid >> 4) + 32 * i) * KS + 8 * (tid & 15)) = R[i];
        if (c < 3) {
#pragma unroll
            for (int i = 0; i < 8; ++i) R[i] = *(const u32x4*)(ksrc + (size_t)(32 * i) * 2048 + (c + 1) * 128);
        }
        __syncthreads();
        if (wid < 4) {
#pragma unroll 2
            for (int ks = 0; ks < 8; ++ks) {
                const bf16x8 qv = *(const bf16x8*)(qp + c * 128 + 16 * ks);
#pragma unroll
                for (int mt = 0; mt < 8; ++mt) st[mt] = MFMA32(*(const LAS bf16x8*)(KL + (32 * mt + x) * KS + 16 * ks + 8 * hi), qv, st[mt]);
            }
        }
    }
    if (wid < 4) {
        float mx = -1e30f;
#pragma unroll
        for (int mt = 0; mt < 8; ++mt)
#pragma unroll
            for (int r = 0; r < 16; ++r) mx = fmaxf(mx, st[mt][r]);
        mx = fmaxf(mx, __shfl_xor(mx, 32));
        float sum = 0.f;
#pragma unroll
        for (int mt = 0; mt < 8; ++mt)
#pragma unroll
            for (int r = 0; r < 16; ++r) { const float p = __builtin_amdgcn_exp2f(st[mt][r] - mx); st[mt][r] = p; sum += p; }
        sum += __shfl_xor(sum, 32);
        const float inv = 1.0f / sum;
        bf16_t* op = PB + qrow * 1024 + head * 256 + 4 * hi;
#pragma unroll
        for (int mt = 0; mt < 8; ++mt)
#pragma unroll
            for (int g = 0; g < 4; ++g) { u32x2 w; w.x = cvtpk(st[mt][4 * g] * inv, st[mt][4 * g + 1] * inv); w.y = cvtpk(st[mt][4 * g + 2] * inv, st[mt][4 * g + 3] * inv); *(u32x2*)(op + 32 * mt + 8 * g) = w; }
    }
}

#define XB_TMO      128
#define XB_XCNT(j)  (256  + 64 * (j))
#define XB_XSUB(j)  (1280 + 64 * (j))
#define XB_XGEN(j)  (2304 + 64 * (j))
#define XB_TOP      3328
#define XB_TOPGEN   3392
#define XCD_BAR_WORDS 3456
#define XB_SPIN_CAP (1u << 18)

__device__ __forceinline__ unsigned xb_ld(unsigned* p)              { return __hip_atomic_load(p, __ATOMIC_RELAXED, __HIP_MEMORY_SCOPE_AGENT); }
__device__ __forceinline__ unsigned xb_add(unsigned* p, unsigned v) { return __hip_atomic_fetch_add(p, v, __ATOMIC_RELAXED, __HIP_MEMORY_SCOPE_AGENT); }
__device__ __forceinline__ unsigned xb_xcc_id() { return (unsigned)__builtin_amdgcn_s_getreg((3 << 11) | 20) & 0xFu; }
#define XB_SPIN(cond, bar) do { unsigned _sp = 0; while (cond) { __builtin_amdgcn_s_sleep(1); \
    if ((++_sp & 255u) == 0u) { if (xb_ld(&(bar)[XB_TMO])) break; if (_sp > XB_SPIN_CAP) { atomicAdd(&(bar)[XB_TMO], 1u); break; } } } } while (0)

struct XcdBarrier {
    unsigned* bar; unsigned x;
    volatile LAS unsigned* st;
};

__device__ __forceinline__ XcdBarrier xcd_barrier_post(unsigned* bar, volatile LAS unsigned* st) {
    XcdBarrier b; b.bar = bar; b.x = xb_xcc_id(); b.st = st;
    if (threadIdx.x == 0) (void)xb_add(&bar[XB_XCNT(b.x)], 1u);
    return b;
}
__device__ __forceinline__ void xcd_barrier_complete(unsigned* bar, unsigned x, unsigned& nloc, unsigned& nx) {
    const unsigned G = gridDim.x * gridDim.y * gridDim.z;
    unsigned sum, cnt, mine, sp = 0u;
    for (;;) {
        sum = 0u; cnt = 0u; mine = 0u;
#pragma unroll
        for (unsigned j = 0; j < 16; ++j) { const unsigned c = xb_ld(&bar[XB_XCNT(j)]); sum += c; cnt += (c > 0u) ? 1u : 0u; mine = (j == x) ? c : mine; }
        if (sum == G) break;
        __builtin_amdgcn_s_sleep(1);
        if ((++sp & 255u) == 0u) { if (xb_ld(&bar[XB_TMO])) break; if (sp > XB_SPIN_CAP) { atomicAdd(&bar[XB_TMO], 1u); break; } }
    }
    nloc = mine > 0u ? mine : 1u; nx = cnt > 0u ? cnt : 1u;
}

__device__ __forceinline__ void xcd_barrier(const XcdBarrier& b) {
    asm volatile("s_waitcnt vmcnt(0)" ::: "memory");
    __syncthreads();
    if (threadIdx.x == 0) {
        unsigned* bar = b.bar;
        __builtin_amdgcn_s_waitcnt(0);
        unsigned nloc = b.st[0], nx = b.st[1];
        if (nloc == 0u) { xcd_barrier_complete(bar, b.x, nloc, nx); b.st[0] = nloc; b.st[1] = nx; }
        const unsigned old = xb_add(&bar[XB_XSUB(b.x)], 1u);
        const unsigned gen = old / nloc;
        if (old + 1u == (gen + 1u) * nloc) {
            __builtin_amdgcn_fence(__ATOMIC_RELEASE, "agent");
            asm volatile("s_waitcnt vmcnt(0)" ::: "memory");
            const unsigned og = xb_add(&bar[XB_TOP], 1u);
            const unsigned tg = og / nx;
            if (og + 1u == (tg + 1u) * nx) xb_add(&bar[XB_TOPGEN], 1u);
            else XB_SPIN(xb_ld(&bar[XB_TOPGEN]) == tg, bar);
            __builtin_amdgcn_fence(__ATOMIC_ACQUIRE, "agent");
            xb_add(&bar[XB_XGEN(b.x)], 1u);
            asm volatile("s_waitcnt vmcnt(0)" ::: "memory");
        } else {
            XB_SPIN(xb_ld(&bar[XB_XGEN(b.x)]) == gen, bar);
            __builtin_amdgcn_fence(__ATOMIC_ACQUIRE, "agent");
            asm volatile("s_waitcnt vmcnt(0)" ::: "memory");
        }
    }
    __syncthreads();
}

struct Args { const float* in[21]; float* out; unsigned char* ws; int ph_lo, ph_hi, sub, pad; };

__global__ void __launch_bounds__(512, 2) mk_fwd(Args a) {
    extern __shared__ __attribute__((aligned(16))) unsigned char lds_raw[];
    LAS unsigned char* lds = (LAS unsigned char*)lds_raw;
    const int tid = threadIdx.x, lane = tid & 63, wid = __builtin_amdgcn_readfirstlane(tid >> 6);
    const int G = gridDim.x, bid = blockIdx.x;
    unsigned char* ws = a.ws;
    float* SSQ0 = (float*)(ws + WS_SSQ0); float* SSQ1 = (float*)(ws + WS_SSQ1); float* SSQ2 = (float*)(ws + WS_SSQ2); float* SSQ3 = (float*)(ws + WS_SSQ3);
    float* SSQ4 = (float*)(ws + WS_SSQ4); float* SSQM = (float*)(ws + WS_SSQM);
    float* C128 = (float*)(ws + WS_C128); float* S128 = (float*)(ws + WS_S128); float* C64 = (float*)(ws + WS_C64); float* S64 = (float*)(ws + WS_S64);
    bf16_t* MEMB = (bf16_t*)(ws + WS_MEMB); bf16_t* XK = (bf16_t*)(ws + WS_XK); bf16_t* XVT = (bf16_t*)(ws + WS_XVT);
    bf16_t* W1GU = (bf16_t*)(ws + WS_W1GU); bf16_t* W1D = (bf16_t*)(ws + WS_W1D); bf16_t* WIN = (bf16_t*)(ws + WS_WIN); bf16_t* WOUT = (bf16_t*)(ws + WS_WOUT);
    bf16_t* WQ = (bf16_t*)(ws + WS_WQ); bf16_t* WKV = (bf16_t*)(ws + WS_WKV); bf16_t* WO = (bf16_t*)(ws + WS_WO); bf16_t* W2GU = (bf16_t*)(ws + WS_W2GU); bf16_t* W2D = (bf16_t*)(ws + WS_W2D);
    bf16_t* XB = (bf16_t*)(ws + WS_XB); bf16_t* MIX = (bf16_t*)(ws + WS_MIX);
    unsigned char* r1 = ws + WS_R1;
    bf16_t* ACT = (bf16_t*)(r1 + R1_ACT); bf16_t* RQ = (bf16_t*)(r1 + R1_RQ); bf16_t* RK = (bf16_t*)(r1 + R1_RK); bf16_t* RV = (bf16_t*)(r1 + R1_RV); bf16_t* RG = (bf16_t*)(r1 + R1_RG);
    bf16_t* SQ = (bf16_t*)(r1 + R1_SQ); bf16_t* SK = (bf16_t*)(r1 + R1_SK); bf16_t* SV = (bf16_t*)(r1 + R1_SV); float* STATE = (float*)(r1 + R1_STATE); bf16_t* SPREV = (bf16_t*)(r1 + R1_SPREV);
    bf16_t* XQ = (bf16_t*)(r1 + R1_XQ); bf16_t* XO = (bf16_t*)(r1 + R1_XO);
    const int lo = a.ph_lo, hi_ph = a.ph_hi;
#ifndef PHMASK
#define PHMASK 0xffffffffu
#endif
#define IN(k) (((PHMASK >> (k)) & 1u) && lo <= (k) && (k) < hi_ph)
#ifndef PHREP
#define PHREP -1
#endif
#ifndef XSYNC
#define XSYNC 0
#endif
#ifndef CG_ALL
#define CG_ALL 0
#endif
#define SEAM(k) do { if (IN(k) && IN((k) + 1)) { if (CG_ALL || lo < 0) cg::this_grid().sync(); else xcd_barrier(xbar); } } while (0)
    XcdBarrier xbar; xbar.bar = (unsigned*)(ws + WS_CTL); xbar.x = 0; xbar.st = nullptr;
    if (hi_ph - lo > 1) {
        volatile LAS unsigned* bst = (volatile LAS unsigned*)(lds + LDS_BAR_OFF);
        if (tid < 2) bst[tid] = 0u;
        __syncthreads();
        xbar = xcd_barrier_post((unsigned*)(ws + WS_CTL), bst);
    }

    if (IN(0)) {
        LAS float* scr = (LAS float*)(lds + wid * 16640);
        const int gw = bid * 8 + wid, ngw = G * 8;
#if !X_LAST
        for (int r = gw; r < T; r += 4 * ngw) rows_to_bf16<4>(a.in[0], XB, SSQ0, r, ngw, T, lane);
        for (int r = gw; r < MEMT; r += ngw) rows_to_bf16<1>(a.in[1], MEMB, SSQM, r, ngw, MEMT, lane);
#endif
        if (G == 256) { tr_all(a.in, ws, scr, gw, ngw, lane, TrRanges{W2GU_SPLIT, 21888, 13184, 15232, WO_IN_P0 ? 15232 : 0, WO_IN_P0 ? 16256 : 0}); tr_all(a.in, ws, scr, gw, ngw, lane, TrRanges{0, 5632, 0, 0, 0, 0}); }
        else tr_all(a.in, ws, scr, gw, ngw, lane, TrRanges{0, TR_NIT, 0, 0, 0, 0});
#if X_LAST
        for (int r = gw; r < T; r += 4 * ngw) rows_to_bf16<4>(a.in[0], XB, SSQ0, r, ngw, T, lane);
        for (int r = gw; r < MEMT; r += ngw) rows_to_bf16<1>(a.in[1], MEMB, SSQM, r, ngw, MEMT, lane);
#endif
        const int gt = bid * 512 + tid, ngt = G * 512;
        for (int i = gt; i < T; i += ngt) { SSQ1[i] = 0.f; SSQ2[i] = 0.f; SSQ3[i] = 0.f; SSQ4[i] = 0.f; }
        for (int i = gt; i < SEQ * 64; i += ngt) {
            const int pos = i >> 6, fi = i & 63;
            {   const float inv = powf(10000.0f, -(float)fi * (1.0f / 64.0f)); const float ang = (float)pos * inv;
                double t = (double)ang * 0.15915494309189535; t -= floor(t + 0.5); const float ar = (float)(t * 6.283185307179586);
                C128[i] = __cosf(ar); S128[i] = __sinf(ar); }
            if (fi < 32) { const float inv = powf(10000.0f, -(float)fi * (1.0f / 32.0f)); const float ang = (float)pos * inv;
                double t = (double)ang * 0.15915494309189535; t -= floor(t + 0.5); const float ar = (float)(t * 6.283185307179586);
                C64[pos * 32 + fi] = __cosf(ar); S64[pos * 32 + fi] = __sinf(ar); }
        }
    }
    SEAM(0);
    if (IN(1)) {
        { pg8::Gemm g{XB, W1GU, T, 2 * FF, D}; pg8::StaticOrder S; S.init(T, 2 * FF, G, bid); EpiSwiGLU E{ACT, SSQ0};
          pg8::gemm_phase<EpiSwiGLU, pg8::StaticOrder, true, GEMM_SP2>(lds, g, S, E); }
        { pg8::Gemm g{MEMB, WKV, MEMT, 2 * D, D}; pg8::StaticOrder S; S.init(MEMT, 2 * D, G, (G == 256) ? ((bid + 128) & 255) : bid); EpiKV E{XK, XVT, SSQM};
          pg8::gemm_phase<EpiKV, pg8::StaticOrder, true, GEMM_SP2>(lds, g, S, E); }
        if (G == 256 && bid >= 160) { __syncthreads(); tr_all(a.in, ws, (LAS float*)(lds + wid * 16640), (bid - 160) * 8 + wid, 96 * 8, lane, TrRanges{5632, 11136, WO_IN_P0 ? 0 : 15232, WO_IN_P0 ? 0 : 16256, 0, 0}); }
    }
    SEAM(1);
    if (IN(2)) { pg8::Gemm g{ACT, W1D, T, D, FF}; pg8::StaticOrder S; S.init(T, D, G, bid); EpiResid<P2_BASE_F32, false> E{a.in[0], nullptr, XB, a.sub ? (float*)(ws + WS_SSQX) : SSQ1, 0.5f};
        pg8::gemm_phase<EpiResid<P2_BASE_F32, false>, pg8::StaticOrder, GEMM_ALIGN1, GEMM_SP2>(lds, g, S, E); }
    SEAM(2);
    if (IN(3)) { pg8::Gemm g{XB, WIN, T, INC, D}; pg8::StaticOrder S; S.init(T, INC, G, bid); EpiWin E{SSQ1, RQ, RK, RV, RG, SQ, SK, SV, C128, S128, C64, S64};
        pg8::gemm_phase<EpiWin, pg8::StaticOrder, true, GEMM_SP2>(lds, g, S, E);
        if (G == 256 && bid >= 160) { __syncthreads(); tr_all(a.in, ws, (LAS float*)(lds + wid * 16640), (bid - 160) * 8 + wid, 96 * 8, lane, TrRanges{11136, 13184, 16256, W2GU_SPLIT, 0, 0});
            __syncthreads();
            if (bid < 224) { pg8::Gemm g2{(const bf16_t*)(ws + WS_WO), XVT, 4 * 2048, 8 * MEML, 512}; VwoOrder S2{bid - 160}; EpiVWo E2{(bf16_t*)(ws + WS_VWOT)};
                pg8::gemm_phase<EpiVWo, VwoOrder, true, GEMM_SP2>(lds, g2, S2, E2); } }
        else if (G != 256) { __syncthreads(); for (int idx = bid; idx < 64; idx += G) { pg8::Gemm g2{(const bf16_t*)(ws + WS_WO), XVT, 4 * 2048, 8 * MEML, 512}; VwoOrder S2{idx}; EpiVWo E2{(bf16_t*)(ws + WS_VWOT)};
                pg8::gemm_phase<EpiVWo, VwoOrder, true, GEMM_SP2>(lds, g2, S2, E2); } } }
    SEAM(3);
    if (IN(4)) {
        for (int it = bid; it < 256; it += G) swa_item(it, lds, SQ, SK, SV, a.in[9], MIX, tid, wid, lane);
        for (int it = 2 * bid; it < 512; it += 2 * G) kv_item2(it, lds, RK, RV, STATE, tid, wid, lane);
    }
    SEAM(4);
    if (IN(5)) {
        for (int idx = bid * 512 + tid; idx < 16 * 16384; idx += G * 512) {
            const int bh = idx >> 14, ed = idx & 16383, h = bh & 7;
            const float lg = lg2gamma(h), gm = exp2f(lg), gC = exp2f(128.0f * lg);
            float v[32];
#pragma unroll
            for (int n = 0; n < 32; ++n) v[n] = STATE[(size_t)(bh * 32 + n) * 16384 + ed];
            float run = 0.f;
#pragma unroll
            for (int n = 0; n < 32; ++n) { SPREV[(size_t)(bh * 32 + n) * 16384 + ed] = (bf16_t)(cvtpk(gm * run, 0.f) & 0xffffu); run = run * gC + v[n]; }
        }
    }
    SEAM(5);
    if (IN(6)) { for (int it = 2 * bid; it < 512; it += 2 * G) ro_item2(it, lds, RQ, RK, RV, RG, SPREV, a.in[8], MIX, tid, wid, lane); }
    SEAM(6);
    if (IN(7)) { pg8::Gemm g{MIX, WOUT, T, D, D}; pg8::StaticOrder S; S.init(T, D, G, bid); EpiResid<false, false> E{nullptr, nullptr, XB, SSQ2, 1.0f};
        pg8::gemm_phase<EpiResid<false, false>, pg8::StaticOrder, GEMM_ALIGN1, GEMM_SP2>(lds, g, S, E); }
    SEAM(7);
    if (IN(8)) { pg8::Gemm g{XB, WQ, T, D, D}; pg8::StaticOrder S; S.init(T, D, G, bid); EpiScale E{XQ, SSQ2, 0.04419417382415922f * LOG2E};
        pg8::gemm_phase<EpiScale, pg8::StaticOrder, GEMM_ALIGN1, GEMM_SP2>(lds, g, S, E); }
    SEAM(8);
    if (IN(9)) { for (int it = bid; it < 256; it += G) xa_item(it, lds, XQ, XK, XO, tid, wid, lane); }
    SEAM(9);
    if (IN(10)) { pg8::Gemm g{XO, (const bf16_t*)(ws + WS_VWOT), T, 2 * D, 2 * 512}; OutOrder S; S.b.init(T, D, G, bid); EpiResid<false, false> E{nullptr, nullptr, XB, SSQ3, 1.0f};
        pg8::gemm_phase<EpiResid<false, false>, OutOrder, GEMM_ALIGN1, GEMM_SP2>(lds, g, S, E); }
    SEAM(10);
    if (IN(11)) { pg8::Gemm g{XB, W2GU, T, 2 * FF, D}; pg8::StaticOrder S; S.init(T, 2 * FF, G, bid); EpiSwiGLU E{ACT, SSQ3};
        pg8::gemm_phase<EpiSwiGLU, pg8::StaticOrder, true, GEMM_SP2>(lds, g, S, E);
        if (G == 256 && bid >= 128) { __syncthreads(); tr_all(a.in, ws, (LAS float*)(lds + wid * 16640), (bid - 128) * 8 + wid, 128 * 8, lane, TrRanges{21888, 24704, 0, 0, 0, 0}); } }
    SEAM(11);
#ifndef FUSE_FINAL
#define FUSE_FINAL 1
#endif
    const bool fuse_final = FUSE_FINAL && G == 256 && hi_ph - lo > 1;
    if (IN(12)) { pg8::Gemm g{ACT, W2D, T, D, FF}; pg8::StaticOrder S; S.init(T, D, G, bid);
        if (fuse_final) { EpiFinal E{a.out, XB, (float*)(ws + WS_XBUF), (unsigned*)(ws + WS_CTL + 16384), a.in[20], 0.5f}; pg8::gemm_phase<EpiFinal, pg8::StaticOrder, false, GEMM_SP2>(lds, g, S, E); }
        else { EpiResid<false, false> E{nullptr, nullptr, XB, SSQ4, 0.5f}; pg8::gemm_phase<EpiResid<false, false>, pg8::StaticOrder, GEMM_ALIGN1, GEMM_SP2>(lds, g, S, E); } }
    if (!fuse_final) SEAM(12);
    if (IN(13) && !fuse_final) {
        const float* fn = a.in[20];
        for (int r = bid * 8 + wid; r < T; r += G * 8) {
            const float rs = rsqrtf(SSQ4[r] * (1.0f / D) + EPS);
            const u32x4* xr = (const u32x4*)(XB + (size_t)r * D) + lane;
            float* orow = a.out + (size_t)r * D + 8 * lane;
#pragma unroll
            for (int j = 0; j < 4; ++j) {
                const u32x4 w = __builtin_nontemporal_load(xr + 64 * j);
                const f32x4 g0 = *(const f32x4*)(fn + 512 * j + 8 * lane), g1 = *(const f32x4*)(fn + 512 * j + 8 * lane + 4);
                const f32x4 h0 = (f32x4){bflo(w.x), bfhi(w.x), bflo(w.y), bfhi(w.y)}, h1 = (f32x4){bflo(w.z), bfhi(w.z), bflo(w.w), bfhi(w.w)};
                __builtin_nontemporal_store(h0 * rs * g0, (f32x4*)(orow + 512 * j)); __builtin_nontemporal_store(h1 * rs * g1, (f32x4*)(orow + 512 * j + 4));
            }
        }
    }
#undef IN
#undef SEAM
}

extern "C" void kernel_launch(void* const* d_in, const int* in_sizes, int n_in, void* d_out, int out_size, void* d_ws, size_t ws_size, hipStream_t stream) {
    static int grid = 0;
    if (grid == 0) {
        if (n_in != 21 || ws_size < WS_END) { fprintf(stderr, "kernel_launch: unexpected inputs (n_in %d, ws %zu)\n", n_in, ws_size); grid = -1; return; }
        int dev = 0, cus = 0, per_cu = 0;
        hipGetDevice(&dev); hipDeviceGetAttribute(&cus, hipDeviceAttributeMultiprocessorCount, dev);
        hipFuncSetAttribute((const void*)mk_fwd, hipFuncAttributeMaxDynamicSharedMemorySize, LDS_BYTES);
        hipOccupancyMaxActiveBlocksPerMultiprocessor(&per_cu, (const void*)mk_fwd, 512, LDS_BYTES);
        if (per_cu < 1) { fprintf(stderr, "kernel_launch: occupancy query says %d blocks per CU\n", per_cu); per_cu = 1; }
        (void)hipGetLastError();
        grid = cus * 1;
    }
    if (grid < 0) return;
    Args a{};
    for (int i = 0; i < 21; ++i) a.in[i] = (const float*)d_in[i];
    a.out = (float*)d_out; a.ws = (unsigned char*)d_ws;
#if MK_SINGLE
    a.ph_lo = 0; a.ph_hi = NPH;
    hipMemsetAsync((unsigned char*)d_ws + WS_CTL, 0, CTL_BYTES, stream);
    void* args[] = {&a};
    hipError_t e = hipLaunchCooperativeKernel((const void*)mk_fwd, dim3(grid), dim3(512), args, LDS_BYTES, stream);
    if (e != hipSuccess) fprintf(stderr, "cooperative launch failed: %s (grid %d)\n", hipGetErrorString(e), grid);
#else
#ifndef FWD_REPS
#define FWD_REPS 1
#endif
    for (int fr_ = 0; fr_ < FWD_REPS; ++fr_)
    for (int p = 0; p < NPH; ++p) { a.ph_lo = p; a.ph_hi = p + 1; const int reps = ((PHREP) == p || ((PHREP) == 456 && p >= 4 && p <= 6)) ? 2 : 1;
        for (int r = 0; r < reps; ++r) { a.sub = r; hipLaunchKernelGGL(mk_fwd, dim3(grid), dim3(512), LDS_BYTES, stream, a); } a.sub = 0; }
#ifdef NOOP_LAUNCHES
    for (int r = 0; r < NOOP_LAUNCHES; ++r) { a.ph_lo = 20; a.ph_hi = 21; hipLaunchKernelGGL(mk_fwd, dim3(grid), dim3(512), LDS_BYTES, stream, a); }
#endif
#endif
}
```

```cpp
#include <hip/hip_runtime.h>
#include <hip/hip_cooperative_groups.h>
#include <cstdio>
#include <cstdint>
namespace cg = cooperative_groups;
#define MK_SINGLE 1
#ifndef PG8_WGM
#define PG8_WGM 8
#endif
#ifndef PG8_ROT
#define PG8_ROT 0
#endif
#ifndef PG8_BAUX
#define PG8_BAUX 0
#endif
namespace pg8 {
#define PG8_LAS __attribute__((address_space(3)))
typedef unsigned short bf16_t;
typedef short bf16x8 __attribute__((ext_vector_type(8)));
typedef float f32x4 __attribute__((ext_vector_type(4)));
typedef unsigned u32x4 __attribute__((ext_vector_type(4)));
constexpr int BM = 256, BK = 64, HALF = 128, HTB = HALF * BK * 2  , STAGE_BYTES = 8 * HTB, NXCD = 8, WGM = PG8_WGM;

__host__ __device__ __forceinline__ int lds_byte(int r, int c) { const int st = (r >> 4) * 2 + (c >> 5), rr = r & 15, cc = c & 31, ob = rr * 64 + cc * 2; return st * 1024 + (ob ^ (((ob >> 9) & 1) << 5)); }
__host__ __device__ __forceinline__ void stage_rc(int b, int& R, int& C) { const int st = b / 1024, sb = b % 1024, swz = sb ^ (((sb >> 9) & 1) << 5); R = (st >> 1) * 16 + swz / 64; C = (st & 1) * 32 + (swz % 64) / 2; }
__host__ __device__ __forceinline__ int perm32(int rho) { const int n = rho >> 4, i = rho & 15; return 8 * (i >> 2) + 4 * n + (i & 3); }

struct Unit { int pm, pn; };
struct Gemm { const bf16_t* A; const bf16_t* Bt; int M, N, K; };

struct StaticOrder {
    int nM, nN, nwg, G, c;
    __host__ __device__ void init(int M, int N, int G_, int c_) { nM = M / BM; nN = N / BM; nwg = nM * nN; G = G_; c = c_; }
    __host__ __device__ bool next(int i, Unit& u) const {
        const long L = (long)i * G + c; if (L >= nwg) return false;
        int wgid = (int)L; { const int q = nwg / NXCD, r = nwg % NXCD, xcd = wgid % NXCD, off = wgid / NXCD; wgid = (xcd < r ? xcd * (q + 1) : r * (q + 1) + (xcd - r) * q) + off; }
        const int nig = WGM * nN, gid = wgid / nig, fm = gid * WGM, gsz = (nM - fm) < WGM ? (nM - fm) : WGM;
        u.pm = fm + ((wgid % nig) % gsz); u.pn = (wgid % nig) / gsz;
#if PG8_ROT
        if (nM == 32 && (nN & 1) == 0 && nN >= 16 && nwg % NXCD == 0) { const int xcd = (int)(L % NXCD), half = nN / 2, base = (xcd & 1) * half; u.pn = base + (u.pn - base + (xcd >> 1) * (half / 4)) % half; }
#endif
        return true;
    }
    __device__ __forceinline__ void a_ready(const Unit&) const {}
    __device__ __forceinline__ void done(const Unit&) const {}
};

template <class Epi, class Sched, bool ALIGN_EPI = false, bool SP2 = false>
__device__ __forceinline__ void gemm_phase(PG8_LAS unsigned char* lds, const Gemm g, const Sched& S, const Epi& E) {
    const int tid = threadIdx.x, wid = __builtin_amdgcn_readfirstlane(tid >> 6), lane = tid & 63, wr = wid >> 2, wc = wid & 3, fr = lane & 15, fq = lane >> 4;
    const int K = g.K, nt = K / BK;
    unsigned voffA[2], voffB[2];
#pragma unroll
    for (int i = 0; i < 2; ++i) { int R, C; stage_rc(tid * 16 + i * 8192, R, C); const int Rb = Epi::PERM ? ((R & ~31) + perm32(R & 31)) : R;
        voffA[i] = (unsigned)(R * K + C) * 2u; voffB[i] = (unsigned)(Rb * K + C) * 2u; }
    const size_t kstep = (size_t)(BK * 2);
    const size_t hstep = (size_t)HALF * K * 2;
    const size_t tstep = 2 * hstep;
    const unsigned ldsw = (unsigned)wid * 1024u;
    const int aoff = lds_byte(wr * 64 + fr, fq * 8), boff = lds_byte(wc * 32 + fr, fq * 8);
#define PG8_SA(b, h) (((b) * 2 + (h)) * HTB)
#define PG8_SB(b, h) ((4 + (b) * 2 + (h)) * HTB)
#define PG8_STAGE(bufoff, gbase, voff) do { _Pragma("unroll") for (int _i = 0; _i < 2; ++_i) \
        __builtin_amdgcn_global_load_lds((const unsigned*)((const char*)(gbase) + (voff)[_i]), (PG8_LAS unsigned*)(lds + (bufoff) + ldsw + _i * 8192), 16, 0, 0); } while (0)
#define PG8_STAGEB(bufoff, gbase, voff) do { _Pragma("unroll") for (int _i = 0; _i < 2; ++_i) \
        __builtin_amdgcn_global_load_lds((const unsigned*)((const char*)(gbase) + (voff)[_i]), (PG8_LAS unsigned*)(lds + (bufoff) + ldsw + _i * 8192), 16, 0, PG8_BAUX); } while (0)
#define PG8_LDA(dst, b, h) do { _Pragma("unroll") for (int m = 0; m < 4; ++m) _Pragma("unroll") for (int k = 0; k < 2; ++k) dst[m][k] = *(const PG8_LAS bf16x8*)(lds + PG8_SA(b, h) + aoff + m * 2048 + k * 1024); } while (0)
#define PG8_LDB(dst, b, h) do { _Pragma("unroll") for (int n = 0; n < 2; ++n) _Pragma("unroll") for (int k = 0; k < 2; ++k) dst[n][k] = *(const PG8_LAS bf16x8*)(lds + PG8_SB(b, h) + boff + n * 2048 + k * 1024); } while (0)
#define PG8_MMA(ai, bj, At, Bt) do { __builtin_amdgcn_s_setprio(1); _Pragma("unroll") for (int m = 0; m < 4; ++m) _Pragma("unroll") for (int n = 0; n < 2; ++n) _Pragma("unroll") for (int k = 0; k < 2; ++k) \
        acc[ai][bj][m][n] = __builtin_amdgcn_mfma_f32_16x16x32_bf16(Bt[n][k], At[m][k], acc[ai][bj][m][n], 0, 0, 0); __builtin_amdgcn_s_setprio(0); } while (0)
#define PG8_WAIT_V(n) asm volatile("s_waitcnt vmcnt(" #n ")" ::: "memory")
#define PG8_WAIT_L(n) asm volatile("s_waitcnt lgkmcnt(" #n ")" ::: "memory")
#define PG8_BAR __builtin_amdgcn_s_barrier()
#define PG8_SCHED __builtin_amdgcn_sched_barrier(0)
    Unit cur, nxt; int ui = 0;
    if (!S.next(0, cur)) return;
    f32x4 acc[2][2][4][2];
#pragma unroll
    for (int a = 0; a < 2; ++a)
#pragma unroll
        for (int b = 0; b < 2; ++b)
#pragma unroll
            for (int m = 0; m < 4; ++m)
#pragma unroll
                for (int n = 0; n < 2; ++n) acc[a][b][m][n] = (f32x4){0.f, 0.f, 0.f, 0.f};
    bf16x8 At[4][2], B0[2][2], B1[2][2];
    const char* cA = (const char*)g.A + (size_t)cur.pm * tstep; const char* cB = (const char*)g.Bt + (size_t)cur.pn * tstep;
    S.a_ready(cur);
    if constexpr (SP2) {
        PG8_STAGEB(PG8_SB(0, 0), cB, voffB); PG8_STAGEB(PG8_SB(0, 1), cB + hstep, voffB); PG8_STAGE(PG8_SA(0, 0), cA, voffA); PG8_STAGE(PG8_SA(0, 1), cA + hstep, voffA);
        if (wr == 1) PG8_BAR;
        PG8_WAIT_V(2); PG8_BAR;
        PG8_STAGEB(PG8_SB(1, 0), cB + kstep, voffB); PG8_STAGE(PG8_SA(1, 0), cA + kstep, voffA); PG8_STAGEB(PG8_SB(1, 1), cB + hstep + kstep, voffB);
        PG8_WAIT_V(6); PG8_BAR;
    } else {
        PG8_STAGEB(PG8_SB(0, 0), cB, voffB); PG8_STAGE(PG8_SA(0, 0), cA, voffA); PG8_STAGEB(PG8_SB(0, 1), cB + hstep, voffB); PG8_STAGE(PG8_SA(0, 1), cA + hstep, voffA);
        if (wr == 1) PG8_BAR;
        PG8_WAIT_V(4); PG8_BAR;
        PG8_STAGEB(PG8_SB(1, 0), cB + kstep, voffB); PG8_STAGE(PG8_SA(1, 0), cA + kstep, voffA); PG8_STAGEB(PG8_SB(1, 1), cB + hstep + kstep, voffB);
        PG8_WAIT_V(6); PG8_BAR;
    }
    for (;;) {
        const bool has_next = S.next(ui + 1, nxt);
        const char* nA = has_next ? (const char*)g.A + (size_t)nxt.pm * tstep : cA; const char* nB = has_next ? (const char*)g.Bt + (size_t)nxt.pn * tstep : cB;
        for (int t = 0; t < nt; t += 2) {
            const bool last = (t == nt - 2);
            const char* a1 = cA + (size_t)(t + 1) * kstep;
            const char* a2 = last ? nA : cA + (size_t)(t + 2) * kstep; const char* b2 = last ? nB : cB + (size_t)(t + 2) * kstep;
            const char* a3 = a2 + kstep; const char* b3 = b2 + kstep;
            if (last && has_next) S.a_ready(nxt);
            if constexpr (SP2) {
            PG8_LDB(B0, 0, 0); PG8_LDB(B1, 0, 1); PG8_SCHED; PG8_LDA(At, 0, 0); PG8_STAGE(PG8_SA(1, 1), a1 + hstep, voffA);
            PG8_WAIT_V(8); PG8_WAIT_L(0); PG8_BAR; PG8_MMA(0, 0, At, B0); PG8_MMA(0, 1, At, B1); PG8_BAR; PG8_SCHED;
            PG8_LDA(At, 0, 1); PG8_STAGEB(PG8_SB(0, 0), b2, voffB); PG8_STAGEB(PG8_SB(0, 1), b2 + hstep, voffB); PG8_STAGE(PG8_SA(0, 0), a2, voffA);
            PG8_WAIT_V(8); PG8_WAIT_L(0); PG8_BAR; PG8_MMA(1, 0, At, B0); PG8_MMA(1, 1, At, B1); PG8_BAR; PG8_SCHED;
            PG8_LDB(B0, 1, 0); PG8_LDB(B1, 1, 1); PG8_SCHED; PG8_LDA(At, 1, 0); PG8_STAGE(PG8_SA(0, 1), a2 + hstep, voffA);
            PG8_WAIT_V(8); PG8_WAIT_L(0); PG8_BAR; PG8_MMA(0, 0, At, B0); PG8_MMA(0, 1, At, B1); PG8_BAR; PG8_SCHED;
            PG8_LDA(At, 1, 1); PG8_STAGEB(PG8_SB(1, 0), b3, voffB); PG8_STAGEB(PG8_SB(1, 1), b3 + hstep, voffB); PG8_STAGE(PG8_SA(1, 0), a3, voffA);
            PG8_WAIT_V(8); PG8_WAIT_L(0); PG8_BAR; PG8_MMA(1, 0, At, B0); PG8_MMA(1, 1, At, B1); PG8_BAR; PG8_SCHED;
            } else {
            PG8_LDB(B0, 0, 0); PG8_SCHED; PG8_LDA(At, 0, 0); PG8_STAGE(PG8_SA(1, 1), a1 + hstep, voffA);
            PG8_WAIT_L(8); PG8_BAR; PG8_WAIT_L(0); PG8_MMA(0, 0, At, B0); PG8_BAR; PG8_SCHED;
            PG8_LDB(B1, 0, 1); PG8_STAGEB(PG8_SB(0, 0), b2, voffB);
            PG8_BAR; PG8_WAIT_L(0); PG8_MMA(0, 1, At, B1); PG8_BAR;
            PG8_LDA(At, 0, 1); PG8_STAGE(PG8_SA(0, 0), a2, voffA);
            PG8_BAR; PG8_WAIT_L(0); PG8_MMA(1, 0, At, B0); PG8_BAR; PG8_SCHED;
            PG8_STAGEB(PG8_SB(0, 1), b2 + hstep, voffB);
            PG8_WAIT_V(6); PG8_BAR; PG8_MMA(1, 1, At, B1); PG8_BAR;
            PG8_LDB(B0, 1, 0); PG8_SCHED; PG8_LDA(At, 1, 0); PG8_STAGE(PG8_SA(0, 1), a2 + hstep, voffA);
            PG8_WAIT_L(8); PG8_BAR; PG8_WAIT_L(0); PG8_MMA(0, 0, At, B0); PG8_BAR; PG8_SCHED;
            PG8_LDB(B1, 1, 1); PG8_STAGEB(PG8_SB(1, 0), b3, voffB);
            PG8_BAR; PG8_WAIT_L(0); PG8_MMA(0, 1, At, B1); PG8_BAR;
            PG8_LDA(At, 1, 1); PG8_STAGE(PG8_SA(1, 0), a3, voffA);
            PG8_BAR; PG8_WAIT_L(0); PG8_MMA(1, 0, At, B0); PG8_BAR; PG8_SCHED;
            PG8_STAGEB(PG8_SB(1, 1), b3 + hstep, voffB);
            PG8_WAIT_V(6); PG8_BAR; PG8_MMA(1, 1, At, B1); PG8_BAR;
            }
        }
        if constexpr (ALIGN_EPI) { if (wr == 0) PG8_BAR; }
        if constexpr (!Epi::AFTER_DRAIN) { E(acc, cur, wr, wc, fr, fq); S.done(cur); }
        if (!has_next) break;
#pragma unroll
        for (int a = 0; a < 2; ++a)
#pragma unroll
            for (int b = 0; b < 2; ++b)
#pragma unroll
                for (int m = 0; m < 4; ++m)
#pragma unroll
                    for (int n = 0; n < 2; ++n) acc[a][b][m][n] = (f32x4){0.f, 0.f, 0.f, 0.f};
        cur = nxt; cA = nA; cB = nB; ++ui;
        if constexpr (ALIGN_EPI) { if (wr == 1) PG8_BAR; }
    }
    PG8_WAIT_V(0);
    if constexpr (!ALIGN_EPI) { if (wr == 0) PG8_BAR; }
    PG8_BAR;
    if constexpr (Epi::AFTER_DRAIN) { E.fused(acc, cur, wr, wc, fr, fq, lds, wid, lane); S.done(cur); }
#undef PG8_SA
#undef PG8_SB
#undef PG8_STAGE
#undef PG8_STAGEB
#undef PG8_LDA
#undef PG8_LDB
#undef PG8_MMA
#undef PG8_WAIT_V
#undef PG8_WAIT_L
#undef PG8_BAR
#undef PG8_SCHED
}
}

using pg8::bf16_t; using pg8::bf16x8; using pg8::f32x4; using pg8::u32x4; using pg8::Unit;
#define LAS __attribute__((address_space(3)))
typedef float f32x16 __attribute__((ext_vector_type(16)));
typedef short s16x4 __attribute__((ext_vector_type(4)));
typedef float f32x2_t __attribute__((ext_vector_type(2)));
typedef __bf16 bf16x2_t __attribute__((ext_vector_type(2)));
typedef unsigned u32x2 __attribute__((ext_vector_type(2)));

constexpr int T = 8192, D = 2048, SEQ = 4096, FF = 5632, INC = 5376, MEMT = 512, MEML = 256;
constexpr float EPS = 1e-6f, LOG2E = 1.4426950408889634f;
constexpr int NPH = 14;
#ifndef GEMM_ALIGNM
#define GEMM_ALIGNM true
#endif
#ifndef STG_NT
#define STG_NT 0
#endif
#ifndef WO_IN_P0
#define WO_IN_P0 1
#endif
#ifndef W2GU_SPLIT
#define W2GU_SPLIT 17792
#endif
#ifndef X_LAST
#define X_LAST 0
#endif
#ifndef P2_BASE_F32
#define P2_BASE_F32 true
#endif
#ifndef GEMM_SP2
#define GEMM_SP2 true
#endif
#ifndef GEMM_ALIGN1
#define GEMM_ALIGN1 true
#endif
#ifndef MK_SINGLE
#define MK_SINGLE 1
#endif

constexpr size_t MiB = 1u << 20;
constexpr size_t WS_SSQX = 262144;
constexpr size_t WS_SSQ0 = 0, WS_SSQ1 = 32768, WS_SSQ2 = 65536, WS_SSQ3 = 98304, WS_SSQ4 = 131072, WS_SSQM = 163840;
constexpr size_t WS_CTL = 196608, CTL_BYTES = 32768, WS_XBUF = 524288;
constexpr int LDS_BAR_OFF = 139264;
constexpr size_t WS_C128 = 1 * MiB, WS_S128 = 2 * MiB, WS_C64 = 3 * MiB, WS_S64 = 3 * MiB + 512 * 1024;
constexpr size_t WS_MEMB = 4 * MiB, WS_XK = 6 * MiB, WS_XVT = 8 * MiB;
constexpr size_t WS_W1GU = 16 * MiB, WS_W1D = 60 * MiB, WS_WIN = 82 * MiB, WS_WOUT = 103 * MiB, WS_WQ = 111 * MiB, WS_WKV = 119 * MiB, WS_WO = 135 * MiB,
                 WS_W2GU = 143 * MiB, WS_W2D = 187 * MiB;
constexpr size_t WS_XB = 209 * MiB, WS_MIX = 241 * MiB, WS_R1 = 273 * MiB, WS_VWOT = 409 * MiB, WS_END = 417 * MiB;
constexpr size_t R1_ACT = 0, R1_RQ = 0, R1_RK = 16 * MiB, R1_RV = 32 * MiB, R1_RG = 48 * MiB, R1_SQ = 64 * MiB, R1_SK = 80 * MiB, R1_SV = 82 * MiB,
                 R1_STATE = 84 * MiB, R1_SPREV = 116 * MiB, R1_XQ = 0, R1_XO = 32 * MiB;
constexpr int LDS_BYTES = 147456;

__device__ __forceinline__ unsigned cvtpk(float lo, float hi) { f32x2_t v = {lo, hi}; bf16x2_t b = __builtin_convertvector(v, bf16x2_t); return __builtin_bit_cast(unsigned, b); }
__device__ __forceinline__ float bf2f(unsigned short b) { return __uint_as_float(((unsigned)b) << 16); }
__device__ __forceinline__ float bflo(unsigned w) { return __uint_as_float(w << 16); }
__device__ __forceinline__ float bfhi(unsigned w) { return __uint_as_float(w & 0xffff0000u); }
__device__ __forceinline__ int crow(int r, int hi) { return (r & 3) + 8 * (r >> 2) + 4 * hi; }
__device__ __forceinline__ float silu_f(float g) { return g * __builtin_amdgcn_rcpf(1.0f + __builtin_amdgcn_exp2f(-g * LOG2E)); }
__device__ __forceinline__ float lg2gamma(int h) { return log2f(1.0f - exp2f(-5.0f - (float)h)); }
__device__ __forceinline__ float wave_sum(float v) {
#pragma unroll
    for (int o = 1; o < 64; o <<= 1) v += __shfl_xor(v, o);
    return v;
}
__device__ __forceinline__ bf16x8 pack8(const f32x16& p, int s) {
    u32x4 w; w.x = cvtpk(p[8 * s + 0], p[8 * s + 1]); w.y = cvtpk(p[8 * s + 2], p[8 * s + 3]); w.z = cvtpk(p[8 * s + 4], p[8 * s + 5]); w.w = cvtpk(p[8 * s + 6], p[8 * s + 7]);
    return __builtin_bit_cast(bf16x8, w);
}
__device__ __forceinline__ bf16x8 lds_cat(const LAS bf16_t* p) {
    const s16x4 a = *(const LAS s16x4*)p, b = *(const LAS s16x4*)(p + 8);
    return __builtin_shufflevector(a, b, 0, 1, 2, 3, 4, 5, 6, 7);
}
__device__ __forceinline__ bf16x8 g_cat(const bf16_t* p) {
    const s16x4 a = *(const s16x4*)p, b = *(const s16x4*)(p + 8);
    return __builtin_shufflevector(a, b, 0, 1, 2, 3, 4, 5, 6, 7);
}
#ifndef WT_STORES
#define WT_STORES 0
#endif
#ifndef EPI_NT
#define EPI_NT 0
#endif
#ifndef ACT_NT
#define ACT_NT 0
#endif
__device__ __forceinline__ void st16(void* p, u32x4 v) {
#if WT_STORES
    asm volatile("global_store_dwordx4 %0, %1, off sc0 sc1" :: "v"(p), "v"(v) : "memory");
#elif EPI_NT
    __builtin_nontemporal_store(v, (u32x4*)p);
#else
    *(u32x4*)p = v;
#endif
}
#define MFMA32(a, b, c) __builtin_amdgcn_mfma_f32_32x32x16_bf16((a), (b), (c), 0, 0, 0)

struct EpiSwiGLU {
    static constexpr bool PERM = true, AFTER_DRAIN = false;
    bf16_t* O;
    __device__ __forceinline__ void operator()(const f32x4 (&acc)[2][2][4][2], const Unit& u, int wr, int wc, int fr, int fq) const {
        const int row0 = u.pm * 256 + wr * 64 + fr, col0 = u.pn * 128 + wc * 32 + 8 * fq;
#pragma unroll
        for (int ai = 0; ai < 2; ++ai)
#pragma unroll
            for (int m = 0; m < 4; ++m) {
                const int row = row0 + ai * 128 + m * 16;
                const float rs = ((const LAS float*)131072)[wr * 64 + fr + ai * 128 + m * 16];
                const float c1 = -rs * LOG2E, c2 = rs * rs;
                float o[8];
#pragma unroll
                for (int n = 0; n < 2; ++n)
#pragma unroll
                    for (int e = 0; e < 4; e += 2) {
                        const f32x2_t g = {acc[ai][0][m][n][e], acc[ai][0][m][n][e + 1]}, up = {acc[ai][1][m][n][e], acc[ai][1][m][n][e + 1]};
                        const f32x2_t t = g * c1; f32x2_t ex; ex.x = __builtin_amdgcn_exp2f(t.x); ex.y = __builtin_amdgcn_exp2f(t.y);
                        const f32x2_t d = ex + 1.0f; f32x2_t sg; sg.x = __builtin_amdgcn_rcpf(d.x); sg.y = __builtin_amdgcn_rcpf(d.y);
                        const f32x2_t r = (g * up) * (sg * c2);
                        o[4 * n + e] = r.x; o[4 * n + e + 1] = r.y;
                    }
                u32x4 w; w.x = cvtpk(o[0], o[1]); w.y = cvtpk(o[2], o[3]); w.z = cvtpk(o[4], o[5]); w.w = cvtpk(o[6], o[7]);
                if (ACT_NT) __builtin_nontemporal_store(w, (u32x4*)(O + (size_t)row * FF + col0)); else st16(O + (size_t)row * FF + col0, w);
            }
    }
};
template <bool BASE_F32, bool OUT_F32> struct EpiResid {
    static constexpr bool PERM = true, AFTER_DRAIN = false;
    const float* base; float* out; bf16_t* xb; float* ssq_out; float scale;
    __device__ __forceinline__ void operator()(const f32x4 (&acc)[2][2][4][2], const Unit& u, int wr, int wc, int fr, int fq) const {
        const int row0 = u.pm * 256 + wr * 64 + fr, col0 = (u.pn & 7) * 256 + wc * 32 + 8 * fq;
#pragma unroll
        for (int ai = 0; ai < 2; ++ai)
#pragma unroll
            for (int m = 0; m < 4; ++m) {
                const int row = row0 + ai * 128 + m * 16; float s = 0.f;
#pragma unroll
                for (int bj = 0; bj < 2; ++bj) {
                    const size_t off = (size_t)row * D + col0 + bj * 128;
                    f32x4 b0, b1;
                    if (BASE_F32) { b0 = __builtin_nontemporal_load((const f32x4*)(base + off)); b1 = __builtin_nontemporal_load((const f32x4*)(base + off + 4)); }
                    else { const u32x4 w = *(const u32x4*)(xb + off); b0 = (f32x4){bflo(w.x), bfhi(w.x), bflo(w.y), bfhi(w.y)}; b1 = (f32x4){bflo(w.z), bfhi(w.z), bflo(w.w), bfhi(w.w)}; }
                    const f32x4 h0 = b0 + acc[ai][bj][m][0] * scale, h1 = b1 + acc[ai][bj][m][1] * scale;
                    if (OUT_F32) { *(f32x4*)(out + off) = h0; *(f32x4*)(out + off + 4) = h1; }
                    else { u32x4 w; w.x = cvtpk(h0[0], h0[1]); w.y = cvtpk(h0[2], h0[3]); w.z = cvtpk(h1[0], h1[1]); w.w = cvtpk(h1[2], h1[3]); st16(xb + off, w); }
                    s += (h0[0] * h0[0] + h0[1] * h0[1]) + (h0[2] * h0[2] + h0[3] * h0[3]) + (h1[0] * h1[0] + h1[1] * h1[1]) + (h1[2] * h1[2] + h1[3] * h1[3]);
                }
                s += __shfl_xor(s, 16); s += __shfl_xor(s, 32);
                if (fq == 0) __hip_atomic_fetch_add(ssq_out + row, s, __ATOMIC_RELAXED, __HIP_MEMORY_SCOPE_AGENT);
            }
    }
};
struct EpiFinal {
    static constexpr bool PERM = true, AFTER_DRAIN = true;
    float* out; const bf16_t* xb; float* xbuf; unsigned* cnt; const float* gain; float scale;
    __device__ __forceinline__ void fused(f32x4 (&acc)[2][2][4][2], const Unit& u, int wr, int wc, int fr, int fq, PG8_LAS unsigned char* lds, int wid, int lane) const {
        LAS float* P = (LAS float*)lds;
        LAS float* S = (LAS float*)(lds + 4096);
        const int col0 = u.pn * 256 + wc * 32 + 8 * fq;
#pragma unroll
        for (int ai = 0; ai < 2; ++ai)
#pragma unroll
            for (int m = 0; m < 4; ++m) {
                const int rl = ai * 128 + wr * 64 + m * 16 + fr; float s = 0.f;
#pragma unroll
                for (int bj = 0; bj < 2; ++bj) {
                    const size_t off = (size_t)(u.pm * 256 + rl) * D + col0 + bj * 128;
                    const u32x4 w = *(const u32x4*)(xb + off);
                    const f32x4 b0 = (f32x4){bflo(w.x), bfhi(w.x), bflo(w.y), bfhi(w.y)}, b1 = (f32x4){bflo(w.z), bfhi(w.z), bflo(w.w), bfhi(w.w)};
                    const f32x4 h0 = b0 + acc[ai][bj][m][0] * scale, h1 = b1 + acc[ai][bj][m][1] * scale;
                    acc[ai][bj][m][0] = h0; acc[ai][bj][m][1] = h1;
                    s += (h0[0] * h0[0] + h0[1] * h0[1]) + (h0[2] * h0[2] + h0[3] * h0[3]) + (h1[0] * h1[0] + h1[1] * h1[1]) + (h1[2] * h1[2] + h1[3] * h1[3]);
                }
                s += __shfl_xor(s, 16); s += __shfl_xor(s, 32);
                if (fq == 0) P[rl * 4 + wc] = s;
            }
        asm volatile("s_waitcnt lgkmcnt(0)" ::: "memory"); __builtin_amdgcn_s_barrier(); asm volatile("" ::: "memory");
        const int row = wid * 32 + (lane & 31);
        if (lane < 32) {
            const float t = (P[row * 4 + 0] + P[row * 4 + 1]) + (P[row * 4 + 2] + P[row * 4 + 3]);
            __hip_atomic_store(xbuf + (size_t)(u.pm * 256 + row) * 8 + u.pn, t, __ATOMIC_RELAXED, __HIP_MEMORY_SCOPE_AGENT);
        }
        asm volatile("s_waitcnt vmcnt(0)" ::: "memory");
        unsigned* c = cnt + 64 * u.pm;
        if (lane == 0) __hip_atomic_fetch_add(c, 1u, __ATOMIC_RELAXED, __HIP_MEMORY_SCOPE_AGENT);
        if (wid == 0) {
            unsigned sp = 0;
            while ((unsigned)__builtin_amdgcn_readfirstlane(__hip_atomic_load(c, __ATOMIC_RELAXED, __HIP_MEMORY_SCOPE_AGENT)) < 64u) { __builtin_amdgcn_s_sleep(2); if (++sp > (1u << 22)) break; }
            __builtin_amdgcn_fence(__ATOMIC_ACQUIRE, "agent");
        }
        asm volatile("s_waitcnt vmcnt(0) lgkmcnt(0)" ::: "memory"); __builtin_amdgcn_s_barrier(); asm volatile("" ::: "memory");
        if (lane < 32) {
            const float* slot = xbuf + (size_t)(u.pm * 256 + row) * 8; float t = 0.f;
#pragma unroll
            for (int k = 0; k < 8; ++k) t += __hip_atomic_load(slot + k, __ATOMIC_RELAXED, __HIP_MEMORY_SCOPE_AGENT);
            S[row] = rsqrtf(t * (1.0f / D) + EPS);
        }
        asm volatile("s_waitcnt vmcnt(0) lgkmcnt(0)" ::: "memory"); __builtin_amdgcn_s_barrier(); asm volatile("" ::: "memory");
        f32x4 g[2][2];
#pragma unroll
        for (int bj = 0; bj < 2; ++bj) { g[bj][0] = *(const f32x4*)(gain + col0 + bj * 128); g[bj][1] = *(const f32x4*)(gain + col0 + bj * 128 + 4); }
#pragma unroll
        for (int ai = 0; ai < 2; ++ai)
#pragma unroll
            for (int m = 0; m < 4; ++m) {
                const int rl = ai * 128 + wr * 64 + m * 16 + fr; const float rs = S[rl];
#pragma unroll
                for (int bj = 0; bj < 2; ++bj) {
                    const size_t off = (size_t)(u.pm * 256 + rl) * D + col0 + bj * 128;
                    *(f32x4*)(out + off) = acc[ai][bj][m][0] * rs * g[bj][0]; *(f32x4*)(out + off + 4) = acc[ai][bj][m][1] * rs * g[bj][1];
                }
            }
    }
};
struct EpiVWo {
    static constexpr bool PERM = true, AFTER_DRAIN = false;
    bf16_t* VWOT;
    __device__ __forceinline__ void operator()(const f32x4 (&acc)[2][2][4][2], const Unit& u, int wr, int wc, int fr, int fq) const {
        const int row0 = u.pm * 256 + wr * 64 + fr, col0 = u.pn * 256 + wc * 32 + 8 * fq;
#pragma unroll
        for (int ai = 0; ai < 2; ++ai)
#pragma unroll
            for (int m = 0; m < 4; ++m) {
                const int row = row0 + ai * 128 + m * 16, n = row & 2047;
#pragma unroll
                for (int bj = 0; bj < 2; ++bj) {
                    const int c = col0 + bj * 128, b = c >> 10, hm = c & 1023;
                    const f32x4 v0 = acc[ai][bj][m][0], v1 = acc[ai][bj][m][1];
                    u32x4 w; w.x = cvtpk(v0[0], v0[1]); w.y = cvtpk(v0[2], v0[3]); w.z = cvtpk(v1[0], v1[1]); w.w = cvtpk(v1[2], v1[3]);
                    *(u32x4*)(VWOT + ((size_t)(b * 2048 + n)) * 1024 + hm) = w;
                }
            }
    }
};
struct VwoOrder {
    int idx;
    __device__ __forceinline__ bool next(int i, Unit& u) const { if (i != 0 || idx < 0 || idx >= 64) return false; const int h = idx >> 4, b = (idx >> 3) & 1; u.pm = h * 8 + (idx & 7); u.pn = b * 4 + h; return true; }
    __device__ __forceinline__ void a_ready(const Unit&) const {}
    __device__ __forceinline__ void done(const Unit&) const {}
};
struct OutOrder {
    pg8::StaticOrder b;
    __device__ __forceinline__ bool next(int i, Unit& u) const { if (!b.next(i, u)) return false; u.pn += 8 * (u.pm >> 4); return true; }
    __device__ __forceinline__ void a_ready(const Unit&) const {}
    __device__ __forceinline__ void done(const Unit&) const {}
};
struct EpiScale {
    static constexpr bool PERM = true, AFTER_DRAIN = false;
    bf16_t* O; const float* ssq; float cs;
    __device__ __forceinline__ void operator()(const f32x4 (&acc)[2][2][4][2], const Unit& u, int wr, int wc, int fr, int fq) const {
        const int row0 = u.pm * 256 + wr * 64 + fr, col0 = u.pn * 256 + wc * 32 + 8 * fq;
#pragma unroll
        for (int ai = 0; ai < 2; ++ai)
#pragma unroll
            for (int m = 0; m < 4; ++m) {
                const int row = row0 + ai * 128 + m * 16;
                const float rs = rsqrtf(ssq[row] * (1.0f / D) + EPS) * cs;
#pragma unroll
                for (int bj = 0; bj < 2; ++bj) {
                    const f32x4 v0 = acc[ai][bj][m][0] * rs, v1 = acc[ai][bj][m][1] * rs;
                    u32x4 w; w.x = cvtpk(v0[0], v0[1]); w.y = cvtpk(v0[2], v0[3]); w.z = cvtpk(v1[0], v1[1]); w.w = cvtpk(v1[2], v1[3]);
                    st16(O + (size_t)row * D + col0 + bj * 128, w);
                }
            }
    }
};
struct EpiKV {
    static constexpr bool PERM = true, AFTER_DRAIN = false;
    bf16_t* XK; bf16_t* XVT; const float* ssq;
    __device__ __forceinline__ void operator()(const f32x4 (&acc)[2][2][4][2], const Unit& u, int wr, int wc, int fr, int fq) const {
        const int row0 = u.pm * 256 + wr * 64 + fr, col0 = u.pn * 256 + wc * 32 + 8 * fq;
#pragma unroll
        for (int ai = 0; ai < 2; ++ai)
#pragma unroll
            for (int m = 0; m < 4; ++m) {
                const int row = row0 + ai * 128 + m * 16;
                const float rs = rsqrtf(ssq[row] * (1.0f / D) + EPS);
#pragma unroll
                for (int bj = 0; bj < 2; ++bj) {
                    const f32x4 v0 = acc[ai][bj][m][0] * rs, v1 = acc[ai][bj][m][1] * rs;
                    const int c = col0 + bj * 128;
                    if (u.pn < 8) {
                        u32x4 w; w.x = cvtpk(v0[0], v0[1]); w.y = cvtpk(v0[2], v0[3]); w.z = cvtpk(v1[0], v1[1]); w.w = cvtpk(v1[2], v1[3]);
                        *(u32x4*)(XK + (size_t)row * D + c) = w;
                    } else {
                        const int cv = c - D;
                        u32x4 w; w.x = cvtpk(v0[0], v0[1]); w.y = cvtpk(v0[2], v0[3]); w.z = cvtpk(v1[0], v1[1]); w.w = cvtpk(v1[2], v1[3]);
                        *(u32x4*)(XVT + ((size_t)(((row >> 8) * 4 + (cv >> 9)) * MEML + (row & 255))) * 512 + (cv & 511)) = w;
                    }
                }
            }
    }
};
struct EpiWin {
    static constexpr bool PERM = true, AFTER_DRAIN = false;
    const float* ssq; bf16_t *RQ, *RK, *RV, *RG, *SQ, *SK, *SV; const float *C128, *S128, *C64, *S64;
    __device__ __forceinline__ void operator()(const f32x4 (&acc)[2][2][4][2], const Unit& u, int wr, int wc, int fr, int fq) const {
        const int row0 = u.pm * 256 + wr * 64 + fr, pn = u.pn;
#pragma unroll
        for (int ai = 0; ai < 2; ++ai)
#pragma unroll
            for (int m = 0; m < 4; ++m) {
                const int row = row0 + ai * 128 + m * 16, pos = row & (SEQ - 1), cp = row & 127;
                const float rs = rsqrtf(ssq[row] * (1.0f / D) + EPS);
                float a[8], b[8];
#pragma unroll
                for (int n = 0; n < 2; ++n)
#pragma unroll
                    for (int e = 0; e < 4; ++e) { a[4 * n + e] = acc[ai][0][m][n][e] * rs; b[4 * n + e] = acc[ai][1][m][n][e] * rs; }
                const bool rope128 = pn < 8, rope64 = (pn >= 16 && pn < 20) || (pn == 20 && wc < 2);
                if (rope128 || rope64) {
                    float cs[8], sn[8]; float sc; bf16_t* dst; int half;
                    if (rope128) {
                        const int sec = pn >> 2, h = 2 * (pn & 3) + (wc >> 1), i0 = (wc & 1) * 32 + 8 * fq;
                        const f32x4 c0 = *(const f32x4*)(C128 + pos * 64 + i0), c1 = *(const f32x4*)(C128 + pos * 64 + i0 + 4);
                        const f32x4 s0 = *(const f32x4*)(S128 + pos * 64 + i0), s1 = *(const f32x4*)(S128 + pos * 64 + i0 + 4);
#pragma unroll
                        for (int e = 0; e < 4; ++e) { cs[e] = c0[e]; cs[4 + e] = c1[e]; sn[e] = s0[e]; sn[4 + e] = s1[e]; }
                        const float lg = lg2gamma(h);
                        sc = sec == 0 ? exp2f((float)cp * lg) : exp2f(-(float)cp * lg) * 0.08838834764831845f;
                        dst = (sec == 0 ? RQ : RK) + (size_t)row * 1024 + h * 128 + i0; half = 64;
                    } else {
                        const int i0 = 8 * fq;
                        const f32x4 c0 = *(const f32x4*)(C64 + pos * 32 + i0), c1 = *(const f32x4*)(C64 + pos * 32 + i0 + 4);
                        const f32x4 s0 = *(const f32x4*)(S64 + pos * 32 + i0), s1 = *(const f32x4*)(S64 + pos * 32 + i0 + 4);
#pragma unroll
                        for (int e = 0; e < 4; ++e) { cs[e] = c0[e]; cs[4 + e] = c1[e]; sn[e] = s0[e]; sn[4 + e] = s1[e]; }
                        if (pn < 20) { sc = 0.125f * LOG2E; dst = SQ + (size_t)row * 1024 + (4 * (pn - 16) + wc) * 64 + i0; }
                        else { sc = 1.0f; dst = SK + (size_t)row * 128 + wc * 64 + i0; }
                        half = 32;
                    }
                    float x1[8], x2[8];
#pragma unroll
                    for (int e = 0; e < 8; ++e) { x1[e] = (a[e] * cs[e] - b[e] * sn[e]) * sc; x2[e] = (b[e] * cs[e] + a[e] * sn[e]) * sc; }
                    u32x4 w1, w2;
                    w1.x = cvtpk(x1[0], x1[1]); w1.y = cvtpk(x1[2], x1[3]); w1.z = cvtpk(x1[4], x1[5]); w1.w = cvtpk(x1[6], x1[7]);
                    w2.x = cvtpk(x2[0], x2[1]); w2.y = cvtpk(x2[2], x2[3]); w2.z = cvtpk(x2[4], x2[5]); w2.w = cvtpk(x2[6], x2[7]);
                    st16(dst, w1); st16(dst + half, w2);
                } else {
                    bf16_t *d0, *d1;
                    if (pn < 12) { d0 = RV + (size_t)row * 1024 + (pn - 8) * 256 + wc * 32 + 8 * fq; d1 = d0 + 128; }
                    else if (pn < 16) {
                        d0 = RG + (size_t)row * 1024 + (pn - 12) * 256 + wc * 32 + 8 * fq; d1 = d0 + 128;
#pragma unroll
                        for (int e = 0; e < 8; ++e) { a[e] = silu_f(a[e]); b[e] = silu_f(b[e]); }
                    } else { d0 = SV + (size_t)row * 128 + (wc - 2) * 32 + 8 * fq; d1 = d0 + 64; }
                    u32x4 w1, w2;
                    w1.x = cvtpk(a[0], a[1]); w1.y = cvtpk(a[2], a[3]); w1.z = cvtpk(a[4], a[5]); w1.w = cvtpk(a[6], a[7]);
                    w2.x = cvtpk(b[0], b[1]); w2.y = cvtpk(b[2], b[3]); w2.z = cvtpk(b[4], b[5]); w2.w = cvtpk(b[6], b[7]);
                    st16(d0, w1); st16(d1, w2);
                }
            }
    }
};

__device__ __forceinline__ int win_src(int d) {
    const int pn = d >> 8, bj = (d >> 7) & 1, o = d & 127;
    if (pn < 8) { const int sec = pn >> 2, pl = pn & 3; return sec * 1024 + (2 * pl + (o >> 6)) * 128 + bj * 64 + (o & 63); }
    if (pn < 16) return d;
    if (pn < 20) { const int pl = pn - 16; return 4096 + (4 * pl + (o >> 5)) * 64 + bj * 32 + (o & 31); }
    if (o < 64) return 5120 + (o >> 5) * 64 + bj * 32 + (o & 31);
    return 5248 + bj * 64 + (o - 64);
}
#ifndef TR_NT
#define TR_NT 1
#endif
#ifndef TR_NTS
#define TR_NTS 1
#endif
#if TR_NT
#define TR_LOAD(p) __builtin_nontemporal_load(p)
#else
#define TR_LOAD(p) (*(p))
#endif
constexpr int TR_NIT = 5632 + 2816 + 2688 + 1024 + 1024 + 2048 + 1024 + 5632 + 2816;
struct TrItem { const float* src; const float* gain; bf16_t* dst; int N, K; bool nts; };
__device__ __forceinline__ TrItem tr_decode(int it, const float* const* in, unsigned char* ws, int lane) {
    int r = it, kind = 0, ndb = 32, N = D, K = D; const float *W, *W2 = nullptr, *gain = nullptr; bf16_t* WT; bool nts = false, woh = false;
    if (r < 5632) { kind = 1; W = in[3]; W2 = in[4]; N = FF; ndb = 176; gain = in[2]; WT = (bf16_t*)(ws + WS_W1GU); }
    else if ((r -= 5632) < 2816) { W = in[5]; K = FF; WT = (bf16_t*)(ws + WS_W1D); }
    else if ((r -= 2816) < 2688) { kind = 2; W = in[7]; N = INC; ndb = 84; gain = in[6]; WT = (bf16_t*)(ws + WS_WIN); nts = true; }
    else if ((r -= 2688) < 1024) { W = in[10]; WT = (bf16_t*)(ws + WS_WOUT); nts = true; }
    else if ((r -= 1024) < 1024) { W = in[13]; gain = in[11]; WT = (bf16_t*)(ws + WS_WQ); nts = true; }
    else if ((r -= 1024) < 2048) { W = in[14]; N = 2 * D; ndb = 64; gain = in[12]; WT = (bf16_t*)(ws + WS_WKV); }
    else if ((r -= 2048) < 1024) { W = in[15]; WT = (bf16_t*)(ws + WS_WO); nts = true; woh = true; }
    else if ((r -= 1024) < 5632) { kind = 1; W = in[17]; W2 = in[18]; N = FF; ndb = 176; gain = in[16]; WT = (bf16_t*)(ws + WS_W2GU); nts = true; }
    else { r -= 5632; W = in[19]; K = FF; WT = (bf16_t*)(ws + WS_W2D); }
#ifndef TR_ORDER
#define TR_ORDER 1
#endif
#if TR_ORDER >= 1
    constexpr int KL = TR_ORDER, DL = 3 - TR_ORDER;
    const int rh = r >> 3, rl = r & 7, nq = ndb >> DL, kbh = rh / nq, dbh = rh - kbh * nq;
    const int kb = (kbh << KL) + (rl >> DL), db = (dbh << DL) + (rl & ((1 << DL) - 1)), d0 = db * 64, k0 = kb * 64;
#else
    const int kb = r / ndb, db = r - kb * ndb, d0 = db * 64, k0 = kb * 64;
#endif
    const int blk = d0 + 32 * ((lane & 15) >> 3);
    const float* src = W; int s0 = blk;
    if (kind == 1) { const int pn = blk >> 8, bj = (blk >> 7) & 1, o = blk & 127; src = bj ? W2 : W; s0 = pn * 128 + o; }
    else if (kind == 2) s0 = win_src(blk);
    TrItem t; t.src = src + (size_t)(k0 + (lane >> 4)) * N + s0 + 4 * (lane & 7); t.gain = gain ? gain + k0 + 8 * (lane & 7) : nullptr;
    t.dst = WT + (size_t)(d0 + (lane >> 3)) * K + k0 + 8 * (lane & 7); t.N = N; t.K = K; t.nts = nts && TR_NTS;
    if (woh) { t.dst = WT + ((size_t)((k0 >> 9) * 2048 + d0 + (lane >> 3))) * 512 + (k0 & 511) + 8 * (lane & 7); t.K = 512; }
    return t;
}
struct TrRanges { int b0, e0, b1, e1, b2, e2;
    __device__ __forceinline__ int count() const { return (e0 - b0) + (e1 - b1) + (e2 - b2); }
    __device__ __forceinline__ int item(int v) const { const int l0 = e0 - b0, l1 = e1 - b1; return v < l0 ? b0 + v : (v < l0 + l1 ? b1 + (v - l0) : b2 + (v - l0 - l1)); } };
__device__ __forceinline__ void tr_all(const float* const* in, unsigned char* ws, LAS float* scr, int gw, int ngw, int lane, const TrRanges rg) {
    const int TR_CNT = rg.count();
    if (gw >= TR_CNT) return;
    TrItem cur = tr_decode(rg.item(gw), in, ws, lane);
    f32x4 v[16];
#pragma unroll
    for (int i = 0; i < 16; ++i) v[i] = TR_LOAD((const f32x4*)(cur.src + (size_t)(4 * i) * cur.N));
    for (int it = gw; it < TR_CNT; it += ngw) {
        const int nit = it + ngw; const bool hn = nit < TR_CNT;
        TrItem nx = cur; f32x4 w[16];
        if (hn) { nx = tr_decode(rg.item(nit), in, ws, lane);
#pragma unroll
            for (int i = 0; i < 16; ++i) w[i] = TR_LOAD((const f32x4*)(nx.src + (size_t)(4 * i) * nx.N)); }
        LAS float* wp = scr + (lane >> 4) * 65 + 4 * (lane & 15);
#pragma unroll
        for (int i = 0; i < 16; ++i) { wp[(4 * i) * 65 + 0] = v[i][0]; wp[(4 * i) * 65 + 1] = v[i][1]; wp[(4 * i) * 65 + 2] = v[i][2]; wp[(4 * i) * 65 + 3] = v[i][3]; }
        f32x4 g0 = {1.f, 1.f, 1.f, 1.f}, g1 = {1.f, 1.f, 1.f, 1.f};
        if (cur.gain) { g0 = *(const f32x4*)cur.gain; g1 = *(const f32x4*)(cur.gain + 4); }
        asm volatile("s_waitcnt lgkmcnt(0)" ::: "memory");
        const LAS float* rp = scr + (8 * (lane & 7)) * 65 + (lane >> 3);
#pragma unroll
        for (int j = 0; j < 8; ++j) { const LAS float* s = rp + 8 * j;
            u32x4 o; o.x = cvtpk(s[0 * 65] * g0[0], s[1 * 65] * g0[1]); o.y = cvtpk(s[2 * 65] * g0[2], s[3 * 65] * g0[3]);
            o.z = cvtpk(s[4 * 65] * g1[0], s[5 * 65] * g1[1]); o.w = cvtpk(s[6 * 65] * g1[2], s[7 * 65] * g1[3]);
            if (cur.nts) __builtin_nontemporal_store(o, (u32x4*)(cur.dst + (size_t)(8 * j) * cur.K)); else *(u32x4*)(cur.dst + (size_t)(8 * j) * cur.K) = o; }
        asm volatile("s_waitcnt lgkmcnt(0)" ::: "memory");
        if (hn) {
#pragma unroll
            for (int i = 0; i < 16; ++i) v[i] = w[i];
            cur = nx; }
    }
}
__device__ __forceinline__ void row_to_bf16(const float* xrow, bf16_t* orow, float* ssq, int lane) {
    float s = 0.f;
#pragma unroll
    for (int j = 0; j < 8; ++j) { const f32x4 v = *((const f32x4*)xrow + lane + 64 * j); s += (v[0] * v[0] + v[1] * v[1]) + (v[2] * v[2] + v[3] * v[3]);
        u32x2 w; w.x = cvtpk(v[0], v[1]); w.y = cvtpk(v[2], v[3]); *((u32x2*)orow + lane + 64 * j) = w; }
    s = wave_sum(s);
    if (lane == 0) *ssq = s;
}

template <int NR>
__device__ __forceinline__ void rows_to_bf16(const float* x, bf16_t* xb, float* ssq, int r, int stride, int nrows, int lane) {
    f32x4 v[NR][8];
#pragma unroll
    for (int k = 0; k < NR; ++k) { const int rr = r + k * stride; if (rr < nrows) {
#pragma unroll
        for (int j = 0; j < 8; ++j) v[k][j] = __builtin_nontemporal_load((const f32x4*)(x + (size_t)rr * D) + lane + 64 * j); } }
#pragma unroll
    for (int k = 0; k < NR; ++k) { const int rr = r + k * stride; if (rr < nrows) {
        float s = 0.f;
#pragma unroll
        for (int j = 0; j < 8; ++j) { const f32x4 t = v[k][j]; s += (t[0] * t[0] + t[1] * t[1]) + (t[2] * t[2] + t[3] * t[3]);
            u32x2 w; w.x = cvtpk(t[0], t[1]); w.y = cvtpk(t[2], t[3]); *((u32x2*)(xb + (size_t)rr * D) + lane + 64 * j) = w; }
        s = wave_sum(s);
        if (lane == 0) ssq[rr] = s; } }
}

__device__ __forceinline__ int swzc(int c, int j) { return j ^ (((c >> 3) & 15) << 3); }
template <int NROWS, int NCOLS, int VS>
__device__ __forceinline__ void stage_T(LAS bf16_t* dstT, const bf16_t* src, long r0, int ld, int col0, long rmin, int tid) {
    constexpr int NCH = NCOLS / 8, TOT = NROWS * NCH;
#pragma unroll
    for (int i = 0; i < TOT / 512; ++i) {
        const int idx = tid + 512 * i;
        int ch, j;
        if (NCH == 16) { ch = (idx & 7) + 8 * ((idx >> 6) & 1); j = ((idx >> 3) & 7) + 8 * (idx >> 7); } else { ch = idx & 7; j = idx >> 3; }
        const long r = r0 + j;
        u32x4 v = {0u, 0u, 0u, 0u};
        if (r >= rmin) v = STG_NT ? __builtin_nontemporal_load((const u32x4*)(src + r * ld + col0 + 8 * ch)) : *(const u32x4*)(src + r * ld + col0 + 8 * ch);
        LAS bf16_t* d = dstT + (8 * ch) * VS + (j ^ ((ch & 15) << 3));
        d[0 * VS] = (bf16_t)(v.x & 0xffffu); d[1 * VS] = (bf16_t)(v.x >> 16); d[2 * VS] = (bf16_t)(v.y & 0xffffu); d[3 * VS] = (bf16_t)(v.y >> 16);
        d[4 * VS] = (bf16_t)(v.z & 0xffffu); d[5 * VS] = (bf16_t)(v.z >> 16); d[6 * VS] = (bf16_t)(v.w & 0xffffu); d[7 * VS] = (bf16_t)(v.w >> 16);
    }
}
template <int VS>
__device__ __forceinline__ bf16x8 lds_cat_sw(const LAS bf16_t* base, int dd, int c0) {
    const LAS bf16_t* rp = base + dd * VS;
    const s16x4 a = *(const LAS s16x4*)(rp + swzc(dd, c0)), b = *(const LAS s16x4*)(rp + swzc(dd, c0 + 8));
    return __builtin_shufflevector(a, b, 0, 1, 2, 3, 4, 5, 6, 7);
}

__device__ __forceinline__ void swa_item(int it, LAS unsigned char* lds, const bf16_t* SQ, const bf16_t* SK, const bf16_t* SV, const float* sinks, bf16_t* MIX, int tid, int wid, int lane) {
    const int hh = it & 1, kvh = (it >> 1) & 1, n = (it >> 2) & 31, b = it >> 7;
    constexpr int VS = 264;
    LAS bf16_t* VT = (LAS bf16_t*)lds;
    const long rb = (long)b * SEQ; const int pos0 = n * 128;
    __syncthreads();
    stage_T<256, 64, VS>(VT, SV, rb + pos0 - 128, 128, kvh * 64, rb, tid);
    __syncthreads();
    const int x = lane & 31, hi = lane >> 5;
#pragma unroll 1
    for (int tk = wid; tk < 16; tk += 8) {
        const int hl = tk >> 2, qt = tk & 3, head = kvh * 8 + hh * 4 + hl;
        const long qrow = rb + pos0 + 32 * qt + x;
        bf16x8 qf[4];
#pragma unroll
        for (int ks = 0; ks < 4; ++ks) qf[ks] = *(const bf16x8*)(SQ + qrow * 1024 + head * 64 + 16 * ks + 8 * hi);
        f32x16 st[5];
#pragma unroll
        for (int t = 0; t < 5; ++t) {
            int kp = pos0 + 32 * qt - 128 + 32 * t + x; if (kp < 0) kp = 0;
            const bf16_t* kptr = SK + (rb + kp) * 128 + kvh * 64 + 8 * hi;
            f32x16 acc = {};
#pragma unroll
            for (int ks = 0; ks < 4; ++ks) acc = MFMA32(*(const bf16x8*)(kptr + 16 * ks), qf[ks], acc);
            st[t] = acc;
        }
        const float sink2 = sinks[head] * LOG2E;
        float mx = sink2;
#pragma unroll
        for (int r = 0; r < 16; ++r) { const int kk = crow(r, hi); if (kk <= x || (n == 0)) st[0][r] = -1e30f; if (kk > x) st[4][r] = -1e30f; }
#pragma unroll
        for (int t = 1; t < 4; ++t) if (n == 0 && qt + t < 4) {
#pragma unroll
            for (int r = 0; r < 16; ++r) st[t][r] = -1e30f; }
#pragma unroll
        for (int t = 0; t < 5; ++t)
#pragma unroll
            for (int r = 0; r < 16; ++r) mx = fmaxf(mx, st[t][r]);
        mx = fmaxf(mx, __shfl_xor(mx, 32));
        float sum = 0.f;
#pragma unroll
        for (int t = 0; t < 5; ++t)
#pragma unroll
            for (int r = 0; r < 16; ++r) { const float p = __builtin_amdgcn_exp2f(st[t][r] - mx); st[t][r] = p; sum += p; }
        sum += __shfl_xor(sum, 32); sum += __builtin_amdgcn_exp2f(sink2 - mx);
        const float inv = 1.0f / sum;
        f32x16 o0 = {}, o1 = {};
#pragma unroll
        for (int t = 0; t < 5; ++t)
#pragma unroll
            for (int s = 0; s < 2; ++s) {
                const bf16x8 pb = pack8(st[t], s);
                const int c0 = 32 * (qt + t) + 16 * s + 4 * hi;
                o0 = MFMA32(lds_cat_sw<VS>(VT, x, c0), pb, o0); o1 = MFMA32(lds_cat_sw<VS>(VT, 32 + x, c0), pb, o1);
                __builtin_amdgcn_sched_barrier(0);
            }
        bf16_t* op = MIX + qrow * 2048 + 1024 + head * 64 + 4 * hi;
#pragma unroll
        for (int g = 0; g < 4; ++g) {
            u32x2 w0, w1; w0.x = cvtpk(o0[4 * g] * inv, o0[4 * g + 1] * inv); w0.y = cvtpk(o0[4 * g + 2] * inv, o0[4 * g + 3] * inv);
            w1.x = cvtpk(o1[4 * g] * inv, o1[4 * g + 1] * inv); w1.y = cvtpk(o1[4 * g + 2] * inv, o1[4 * g + 3] * inv);
            *(u32x2*)(op + 8 * g) = w0; *(u32x2*)(op + 32 + 8 * g) = w1;
        }
    }
}

__device__ __forceinline__ void kv_item2(int it0, LAS unsigned char* lds, const bf16_t* RK, const bf16_t* RV, float* STATE, int tid, int wid, int lane) {
    constexpr int VS = 136, TILE = 128 * VS;
    LAS bf16_t* L = (LAS bf16_t*)lds;
    __syncthreads();
#pragma unroll
    for (int k = 0; k < 2; ++k) {
        const int it = it0 + k, bh = it >> 5, n = it & 31, b = bh >> 3, h = bh & 7; const long r0 = (long)b * SEQ + n * 128;
        stage_T<128, 128, VS>(L + (2 * k) * TILE, RK, r0, 1024, h * 128, 0, tid);
        stage_T<128, 128, VS>(L + (2 * k + 1) * TILE, RV, r0, 1024, h * 128, 0, tid);
    }
    __syncthreads();
    const int half = wid >> 2, it = it0 + half, h = (it >> 5) & 7;
    const LAS bf16_t* KT = L + (2 * half) * TILE; const LAS bf16_t* VT = KT + TILE;
    const int x = lane & 31, hi = lane >> 5, et = wid & 3;
    f32x16 acc[4];
#pragma unroll
    for (int dt = 0; dt < 4; ++dt) acc[dt] = f32x16{};
#pragma unroll
    for (int ks = 0; ks < 8; ++ks) {
        const int ea = 32 * et + x, cc = 16 * ks + 8 * hi;
        const bf16x8 A = *(const LAS bf16x8*)(VT + ea * VS + swzc(ea, cc));
#pragma unroll
        for (int dt = 0; dt < 4; ++dt) { const int da = 32 * dt + x; acc[dt] = MFMA32(A, *(const LAS bf16x8*)(KT + da * VS + swzc(da, cc)), acc[dt]); }
    }
    const float g127 = exp2f(127.0f * lg2gamma(h));
    float* sp = STATE + (size_t)it * 16384;
#pragma unroll
    for (int dt = 0; dt < 4; ++dt)
#pragma unroll
        for (int r = 0; r < 16; ++r) sp[(32 * et + crow(r, hi)) * 128 + 32 * dt + x] = acc[dt][r] * g127;
}

__device__ __forceinline__ void ro_item2(int it0, LAS unsigned char* lds, const bf16_t* RQ, const bf16_t* RK, const bf16_t* RV, const bf16_t* RG, const bf16_t* SPREV, const float* GN, bf16_t* MIX,
                                         int tid, int wid, int lane) {
    constexpr int VS = 136, TILE = 128 * VS;
    LAS bf16_t* L = (LAS bf16_t*)lds;
    __syncthreads();
#pragma unroll
    for (int k = 0; k < 2; ++k) {
        const int it = it0 + k, bh = it >> 5, n = it & 31, b = bh >> 3, h = bh & 7;
        stage_T<128, 128, VS>(L + k * TILE, RV, (long)b * SEQ + n * 128, 1024, h * 128, 0, tid);
    }
    __syncthreads();
    const int half = wid >> 2, it = it0 + half, bh = it >> 5, n = it & 31, b = bh >> 3, h = bh & 7;
    const LAS bf16_t* VT = L + half * TILE;
    const long r0 = (long)b * SEQ + n * 128;
    const int x = lane & 31, hi = lane >> 5, ct = wid & 3;
    const long qrow = r0 + 32 * ct + x;
    bf16x8 qf[8];
#pragma unroll
    for (int ks = 0; ks < 8; ++ks) qf[ks] = *(const bf16x8*)(RQ + qrow * 1024 + h * 128 + 16 * ks + 8 * hi);
    f32x16 o[4];
#pragma unroll
    for (int et = 0; et < 4; ++et) o[et] = f32x16{};
    for (int jt = 0; jt <= ct; ++jt) {
        f32x16 st = {};
        const bf16_t* kptr = RK + (r0 + 32 * jt + x) * 1024 + h * 128 + 8 * hi;
#pragma unroll
        for (int ks = 0; ks < 8; ++ks) st = MFMA32(*(const bf16x8*)(kptr + 16 * ks), qf[ks], st);
        if (jt == ct) {
#pragma unroll
            for (int r = 0; r < 16; ++r) if (crow(r, hi) > x) st[r] = 0.f;
        }
#pragma unroll
        for (int s2 = 0; s2 < 2; ++s2) {
            const bf16x8 pb = pack8(st, s2);
#pragma unroll
            for (int et = 0; et < 4; ++et) o[et] = MFMA32(lds_cat_sw<VS>(VT, 32 * et + x, 32 * jt + 16 * s2 + 4 * hi), pb, o[et]);
        }
    }
    const bf16_t* sp = SPREV + (size_t)it * 16384;
#pragma unroll
    for (int et = 0; et < 4; ++et)
#pragma unroll
        for (int ks = 0; ks < 8; ++ks) o[et] = MFMA32(*(const bf16x8*)(sp + (32 * et + x) * 128 + 16 * ks + 8 * hi), qf[ks], o[et]);
    float s1 = 0.f, s2 = 0.f;
#pragma unroll
    for (int et = 0; et < 4; ++et)
#pragma unroll
        for (int r = 0; r < 16; ++r) { s1 += o[et][r]; s2 += o[et][r] * o[et][r]; }
    s1 += __shfl_xor(s1, 32); s2 += __shfl_xor(s2, 32);
    const float mean = s1 * (1.0f / 128.0f), var = fmaxf(s2 * (1.0f / 128.0f) - mean * mean, 0.f), rstd = rsqrtf(var + EPS);
#pragma unroll
    for (int et = 0; et < 4; ++et)
#pragma unroll
        for (int g = 0; g < 4; ++g) {
            const int e0 = 32 * et + 8 * g + 4 * hi;
            const u32x2 gt = *(const u32x2*)(RG + qrow * 1024 + h * 128 + e0);
            const f32x4 gn = *(const f32x4*)(GN + h * 128 + e0);
            const float y0 = (o[et][4 * g] - mean) * rstd * gn[0] * bflo(gt.x), y1 = (o[et][4 * g + 1] - mean) * rstd * gn[1] * bfhi(gt.x);
            const float y2 = (o[et][4 * g + 2] - mean) * rstd * gn[2] * bflo(gt.y), y3 = (o[et][4 * g + 3] - mean) * rstd * gn[3] * bfhi(gt.y);
            u32x2 w; w.x = cvtpk(y0, y1); w.y = cvtpk(y2, y3);
            *(u32x2*)(MIX + qrow * 2048 + h * 128 + e0) = w;
        }
}

__device__ __forceinline__ void xa_item(int it, LAS unsigned char* lds, const bf16_t* XQ, const bf16_t* XK, bf16_t* PB, int tid, int wid, int lane) {
    const int qb = it & 31, head = (it >> 5) & 3, b = it >> 7;
    const int x = lane & 31, hi = lane >> 5;
    constexpr int KS = 136;
    LAS bf16_t* KL = (LAS bf16_t*)lds;
    const long qrow = (long)b * SEQ + qb * 128 + 32 * (wid & 3) + x;
    const bf16_t* qp = XQ + qrow * 2048 + head * 512 + 8 * hi;
    const bf16_t* ksrc = XK + (size_t)(b * MEML + (tid >> 4)) * 2048 + head * 512 + 8 * (tid & 15);
    u32x4 R[8];
#pragma unroll
    for (int i = 0; i < 8; ++i) R[i] = *(const u32x4*)(ksrc + (size_t)(32 * i) * 2048);
    f32x16 st[8];
#pragma unroll
    for (int mt = 0; mt < 8; ++mt) st[mt] = f32x16{};
#pragma unroll 1
    for (int c = 0; c < 4; ++c) {
        __syncthreads();
#pragma unroll
        for (int i = 0; i < 8; ++i) *(LAS u32x4*)(KL + ((tid >> 4) + 32 * i) * KS + 8 * (tid & 15)) = R[i];
        if (c < 3) {
#pragma unroll
            for (int i = 0; i < 8; ++i) R[i] = *(const u32x4*)(ksrc + (size_t)(32 * i) * 2048 + (c + 1) * 128);
        }
        __syncthreads();
        if (wid < 4) {
#pragma unroll 2
            for (int ks = 0; ks < 8; ++ks) {
                const bf16x8 qv = *(const bf16x8*)(qp + c * 128 + 16 * ks);
#pragma unroll
                for (int mt = 0; mt < 8; ++mt) st[mt] = MFMA32(*(const LAS bf16x8*)(KL + (32 * mt + x) * KS + 16 * ks + 8 * hi), qv, st[mt]);
            }
        }
    }
    if (wid < 4) {
        float mx = -1e30f;
#pragma unroll
        for (int mt = 0; mt < 8; ++mt)
#pragma unroll
            for (int r = 0; r < 16; ++r) mx = fmaxf(mx, st[mt][r]);
        mx = fmaxf(mx, __shfl_xor(mx, 32));
        float sum = 0.f;
#pragma unroll
        for (int mt = 0; mt < 8; ++mt)
#pragma unroll
            for (int r = 0; r < 16; ++r) { const float p = __builtin_amdgcn_exp2f(st[mt][r] - mx); st[mt][r] = p; sum += p; }
        sum += __shfl_xor(sum, 32);
        const float inv = 1.0f / sum;
        bf16_t* op = PB + qrow * 1024 + head * 256 + 4 * hi;
#pragma unroll
        for (int mt = 0; mt < 8; ++mt)
#pragma unroll
            for (int g = 0; g < 4; ++g) { u32x2 w; w.x = cvtpk(st[mt][4 * g] * inv, st[mt][4 * g + 1] * inv); w.y = cvtpk(st[mt][4 * g + 2] * inv, st[mt][4 * g + 3] * inv); *(u32x2*)(op + 32 * mt + 8 * g) = w; }
    }
}

#define XB_TMO      128
#define XB_XCNT(j)  (256  + 64 * (j))
#define XB_XSUB(j)  (1280 + 64 * (j))
#define XB_XGEN(j)  (2304 + 64 * (j))
#define XB_TOP      3328
#define XB_TOPGEN   3392
#define XCD_BAR_WORDS 3456
#define XB_SPIN_CAP (1u << 18)

__device__ __forceinline__ unsigned xb_ld(unsigned* p)              { return __hip_atomic_load(p, __ATOMIC_RELAXED, __HIP_MEMORY_SCOPE_AGENT); }
__device__ __forceinline__ unsigned xb_add(unsigned* p, unsigned v) { return __hip_atomic_fetch_add(p, v, __ATOMIC_RELAXED, __HIP_MEMORY_SCOPE_AGENT); }
__device__ __forceinline__ unsigned xb_xcc_id() { return (unsigned)__builtin_amdgcn_s_getreg((3 << 11) | 20) & 0xFu; }
#define XB_SPIN(cond, bar) do { unsigned _sp = 0; while (cond) { __builtin_amdgcn_s_sleep(1); \
    if ((++_sp & 255u) == 0u) { if (xb_ld(&(bar)[XB_TMO])) break; if (_sp > XB_SPIN_CAP) { atomicAdd(&(bar)[XB_TMO], 1u); break; } } } } while (0)

struct XcdBarrier {
    unsigned* bar; unsigned x;
    volatile LAS unsigned* st;
};

__device__ __forceinline__ XcdBarrier xcd_barrier_post(unsigned* bar, volatile LAS unsigned* st) {
    XcdBarrier b; b.bar = bar; b.x = xb_xcc_id(); b.st = st;
    if (threadIdx.x == 0) (void)xb_add(&bar[XB_XCNT(b.x)], 1u);
    return b;
}
__device__ __forceinline__ void xcd_barrier_complete(unsigned* bar, unsigned x, unsigned& nloc, unsigned& nx) {
    const unsigned G = gridDim.x * gridDim.y * gridDim.z;
    unsigned sum, cnt, mine, sp = 0u;
    for (;;) {
        sum = 0u; cnt = 0u; mine = 0u;
#pragma unroll
        for (unsigned j = 0; j < 16; ++j) { const unsigned c = xb_ld(&bar[XB_XCNT(j)]); sum += c; cnt += (c > 0u) ? 1u : 0u; mine = (j == x) ? c : mine; }
        if (sum == G) break;
        __builtin_amdgcn_s_sleep(1);
        if ((++sp & 255u) == 0u) { if (xb_ld(&bar[XB_TMO])) break; if (sp > XB_SPIN_CAP) { atomicAdd(&bar[XB_TMO], 1u); break; } }
    }
    nloc = mine > 0u ? mine : 1u; nx = cnt > 0u ? cnt : 1u;
}

__device__ __forceinline__ void xcd_barrier(const XcdBarrier& b) {
    asm volatile("s_waitcnt vmcnt(0)" ::: "memory");
    __syncthreads();
    if (threadIdx.x == 0) {
        unsigned* bar = b.bar;
        __builtin_amdgcn_s_waitcnt(0);
        unsigned nloc = b.st[0], nx = b.st[1];
        if (nloc == 0u) { xcd_barrier_complete(bar, b.x, nloc, nx); b.st[0] = nloc; b.st[1] = nx; }
        const unsigned old = xb_add(&bar[XB_XSUB(b.x)], 1u);
        const unsigned gen = old / nloc;
        if (old + 1u == (gen + 1u) * nloc) {
            __builtin_amdgcn_fence(__ATOMIC_RELEASE, "agent");
            asm volatile("s_waitcnt vmcnt(0)" ::: "memory");
            const unsigned og = xb_add(&bar[XB_TOP], 1u);
            const unsigned tg = og / nx;
            if (og + 1u == (tg + 1u) * nx) xb_add(&bar[XB_TOPGEN], 1u);
            else XB_SPIN(xb_ld(&bar[XB_TOPGEN]) == tg, bar);
            __builtin_amdgcn_fence(__ATOMIC_ACQUIRE, "agent");
            xb_add(&bar[XB_XGEN(b.x)], 1u);
            asm volatile("s_waitcnt vmcnt(0)" ::: "memory");
        } else {
            XB_SPIN(xb_ld(&bar[XB_XGEN(b.x)]) == gen, bar);
            __builtin_amdgcn_fence(__ATOMIC_ACQUIRE, "agent");
            asm volatile("s_waitcnt vmcnt(0)" ::: "memory");
        }
    }
    __syncthreads();
}

struct Args { const float* in[21]; float* out; unsigned char* ws; int ph_lo, ph_hi, sub, pad; };

__global__ void __launch_bounds__(512, 2) mk_fwd(Args a) {
    extern __shared__ __attribute__((aligned(16))) unsigned char lds_raw[];
    LAS unsigned char* lds = (LAS unsigned char*)lds_raw;
    const int tid = threadIdx.x, lane = tid & 63, wid = __builtin_amdgcn_readfirstlane(tid >> 6);
    const int G = gridDim.x, bid = blockIdx.x;
    unsigned char* ws = a.ws;
    float* SSQ0 = (float*)(ws + WS_SSQ0); float* SSQ1 = (float*)(ws + WS_SSQ1); float* SSQ2 = (float*)(ws + WS_SSQ2); float* SSQ3 = (float*)(ws + WS_SSQ3);
    float* SSQ4 = (float*)(ws + WS_SSQ4); float* SSQM = (float*)(ws + WS_SSQM);
    float* C128 = (float*)(ws + WS_C128); float* S128 = (float*)(ws + WS_S128); float* C64 = (float*)(ws + WS_C64); float* S64 = (float*)(ws + WS_S64);
    bf16_t* MEMB = (bf16_t*)(ws + WS_MEMB); bf16_t* XK = (bf16_t*)(ws + WS_XK); bf16_t* XVT = (bf16_t*)(ws + WS_XVT);
    bf16_t* W1GU = (bf16_t*)(ws + WS_W1GU); bf16_t* W1D = (bf16_t*)(ws + WS_W1D); bf16_t* WIN = (bf16_t*)(ws + WS_WIN); bf16_t* WOUT = (bf16_t*)(ws + WS_WOUT);
    bf16_t* WQ = (bf16_t*)(ws + WS_WQ); bf16_t* WKV = (bf16_t*)(ws + WS_WKV); bf16_t* WO = (bf16_t*)(ws + WS_WO); bf16_t* W2GU = (bf16_t*)(ws + WS_W2GU); bf16_t* W2D = (bf16_t*)(ws + WS_W2D);
    bf16_t* XB = (bf16_t*)(ws + WS_XB); bf16_t* MIX = (bf16_t*)(ws + WS_MIX);
    unsigned char* r1 = ws + WS_R1;
    bf16_t* ACT = (bf16_t*)(r1 + R1_ACT); bf16_t* RQ = (bf16_t*)(r1 + R1_RQ); bf16_t* RK = (bf16_t*)(r1 + R1_RK); bf16_t* RV = (bf16_t*)(r1 + R1_RV); bf16_t* RG = (bf16_t*)(r1 + R1_RG);
    bf16_t* SQ = (bf16_t*)(r1 + R1_SQ); bf16_t* SK = (bf16_t*)(r1 + R1_SK); bf16_t* SV = (bf16_t*)(r1 + R1_SV); float* STATE = (float*)(r1 + R1_STATE); bf16_t* SPREV = (bf16_t*)(r1 + R1_SPREV);
    bf16_t* XQ = (bf16_t*)(r1 + R1_XQ); bf16_t* XO = (bf16_t*)(r1 + R1_XO);
    const int lo = a.ph_lo, hi_ph = a.ph_hi;
#ifndef PHMASK
#define PHMASK 0xffffffffu
#endif
#define IN(k) (((PHMASK >> (k)) & 1u) && lo <= (k) && (k) < hi_ph)
#ifndef PHREP
#define PHREP -1
#endif
#ifndef XSYNC
#define XSYNC 0
#endif
#ifndef CG_ALL
#define CG_ALL 0
#endif
#define RS_TABLE(S_, ssq_) do { const int pm0_ = 8 * ((bid & 7) >> 1) + ((bid >> 3) & 7);     \
        if (tid < 256) ((LAS float*)(lds + 131072))[tid] = rsqrtf((ssq_)[pm0_ * 256 + tid] * (1.0f / D) + EPS); __syncthreads(); } while (0)
#define SEAM(k) do { if (IN(k) && IN((k) + 1)) { if (CG_ALL || lo < 0) cg::this_grid().sync(); else xcd_barrier(xbar); } } while (0)
    XcdBarrier xbar; xbar.bar = (unsigned*)(ws + WS_CTL); xbar.x = 0; xbar.st = nullptr;
    if (hi_ph - lo > 1) {
        volatile LAS unsigned* bst = (volatile LAS unsigned*)(lds + LDS_BAR_OFF);
        if (tid < 2) bst[tid] = 0u;
        __syncthreads();
        xbar = xcd_barrier_post((unsigned*)(ws + WS_CTL), bst);
    }

    if (IN(0)) {
        LAS float* scr = (LAS float*)(lds + wid * 16640);
        const int gw = bid * 8 + wid, ngw = G * 8;
#if !X_LAST
        for (int r = gw; r < T; r += 4 * ngw) rows_to_bf16<4>(a.in[0], XB, SSQ0, r, ngw, T, lane);
        for (int r = gw; r < MEMT; r += ngw) rows_to_bf16<1>(a.in[1], MEMB, SSQM, r, ngw, MEMT, lane);
#endif
        if (G == 256) { tr_all(a.in, ws, scr, gw, ngw, lane, TrRanges{W2GU_SPLIT, 21888, 13184, 15232, WO_IN_P0 ? 15232 : 0, WO_IN_P0 ? 16256 : 0}); tr_all(a.in, ws, scr, gw, ngw, lane, TrRanges{0, 5632, 0, 0, 0, 0}); }
        else tr_all(a.in, ws, scr, gw, ngw, lane, TrRanges{0, TR_NIT, 0, 0, 0, 0});
#if X_LAST
        for (int r = gw; r < T; r += 4 * ngw) rows_to_bf16<4>(a.in[0], XB, SSQ0, r, ngw, T, lane);
        for (int r = gw; r < MEMT; r += ngw) rows_to_bf16<1>(a.in[1], MEMB, SSQM, r, ngw, MEMT, lane);
#endif
        const int gt = bid * 512 + tid, ngt = G * 512;
        for (int i = gt; i < T; i += ngt) { SSQ1[i] = 0.f; SSQ2[i] = 0.f; SSQ3[i] = 0.f; SSQ4[i] = 0.f; }
        for (int i = gt; i < SEQ * 64; i += ngt) {
            const int pos = i >> 6, fi = i & 63;
            {   const float inv = powf(10000.0f, -(float)fi * (1.0f / 64.0f)); const float ang = (float)pos * inv;
                double t = (double)ang * 0.15915494309189535; t -= floor(t + 0.5); const float ar = (float)(t * 6.283185307179586);
                C128[i] = __cosf(ar); S128[i] = __sinf(ar); }
            if (fi < 32) { const float inv = powf(10000.0f, -(float)fi * (1.0f / 32.0f)); const float ang = (float)pos * inv;
                double t = (double)ang * 0.15915494309189535; t -= floor(t + 0.5); const float ar = (float)(t * 6.283185307179586);
                C64[pos * 32 + fi] = __cosf(ar); S64[pos * 32 + fi] = __sinf(ar); }
        }
    }
    SEAM(0);
    if (IN(1)) {
        { pg8::Gemm g{XB, W1GU, T, 2 * FF, D}; pg8::StaticOrder S; S.init(T, 2 * FF, G, bid); RS_TABLE(S, SSQ0);
          EpiSwiGLU E{ACT}; pg8::gemm_phase<EpiSwiGLU, pg8::StaticOrder, GEMM_ALIGNM, GEMM_SP2>(lds, g, S, E); }
        { pg8::Gemm g{MEMB, WKV, MEMT, 2 * D, D}; pg8::StaticOrder S; S.init(MEMT, 2 * D, G, (G == 256) ? ((bid + 128) & 255) : bid); EpiKV E{XK, XVT, SSQM};
          pg8::gemm_phase<EpiKV, pg8::StaticOrder, GEMM_ALIGNM, GEMM_SP2>(lds, g, S, E); }
        if (G == 256 && bid >= 160) { __syncthreads(); tr_all(a.in, ws, (LAS float*)(lds + wid * 16640), (bid - 160) * 8 + wid, 96 * 8, lane, TrRanges{5632, 11136, WO_IN_P0 ? 0 : 15232, WO_IN_P0 ? 0 : 16256, 0, 0}); }
    }
    SEAM(1);
    if (IN(2)) { pg8::Gemm g{ACT, W1D, T, D, FF}; pg8::StaticOrder S; S.init(T, D, G, bid); EpiResid<P2_BASE_F32, false> E{a.in[0], nullptr, XB, a.sub ? (float*)(ws + WS_SSQX) : SSQ1, 0.5f};
        pg8::gemm_phase<EpiResid<P2_BASE_F32, false>, pg8::StaticOrder, GEMM_ALIGN1, GEMM_SP2>(lds, g, S, E); }
    SEAM(2);
    if (IN(3)) { pg8::Gemm g{XB, WIN, T, INC, D}; pg8::StaticOrder S; S.init(T, INC, G, bid); EpiWin E{SSQ1, RQ, RK, RV, RG, SQ, SK, SV, C128, S128, C64, S64};
        pg8::gemm_phase<EpiWin, pg8::StaticOrder, GEMM_ALIGNM, GEMM_SP2>(lds, g, S, E);
        if (G == 256 && bid >= 160) { __syncthreads(); tr_all(a.in, ws, (LAS float*)(lds + wid * 16640), (bid - 160) * 8 + wid, 96 * 8, lane, TrRanges{11136, 13184, 16256, W2GU_SPLIT, 0, 0});
            __syncthreads();
            if (bid < 224) { pg8::Gemm g2{(const bf16_t*)(ws + WS_WO), XVT, 4 * 2048, 8 * MEML, 512}; VwoOrder S2{bid - 160}; EpiVWo E2{(bf16_t*)(ws + WS_VWOT)};
                pg8::gemm_phase<EpiVWo, VwoOrder, true, GEMM_SP2>(lds, g2, S2, E2); } }
}
    SEAM(3);
    if (IN(4)) {
        for (int it = bid; it < 256; it += G) swa_item(it, lds, SQ, SK, SV, a.in[9], MIX, tid, wid, lane);
        for (int it = 2 * bid; it < 512; it += 2 * G) kv_item2(it, lds, RK, RV, STATE, tid, wid, lane);
    }
    SEAM(4);
    if (IN(5)) {
        for (int idx = bid * 512 + tid; idx < 16 * 16384; idx += G * 512) {
            const int bh = idx >> 14, ed = idx & 16383, h = bh & 7;
            const float lg = lg2gamma(h), gm = exp2f(lg), gC = exp2f(128.0f * lg);
            float v[32];
#pragma unroll
            for (int n = 0; n < 32; ++n) v[n] = STATE[(size_t)(bh * 32 + n) * 16384 + ed];
            float run = 0.f;
#pragma unroll
            for (int n = 0; n < 32; ++n) { SPREV[(size_t)(bh * 32 + n) * 16384 + ed] = (bf16_t)(cvtpk(gm * run, 0.f) & 0xffffu); run = run * gC + v[n]; }
        }
    }
    SEAM(5);
    if (IN(6)) { for (int it = 2 * bid; it < 512; it += 2 * G) ro_item2(it, lds, RQ, RK, RV, RG, SPREV, a.in[8], MIX, tid, wid, lane); }
    SEAM(6);
    if (IN(7)) { pg8::Gemm g{MIX, WOUT, T, D, D}; pg8::StaticOrder S; S.init(T, D, G, bid); EpiResid<false, false> E{nullptr, nullptr, XB, SSQ2, 1.0f};
        pg8::gemm_phase<EpiResid<false, false>, pg8::StaticOrder, GEMM_ALIGN1, GEMM_SP2>(lds, g, S, E); }
    SEAM(7);
    if (IN(8)) { pg8::Gemm g{XB, WQ, T, D, D}; pg8::StaticOrder S; S.init(T, D, G, bid); EpiScale E{XQ, SSQ2, 0.04419417382415922f * LOG2E};
        pg8::gemm_phase<EpiScale, pg8::StaticOrder, GEMM_ALIGN1, GEMM_SP2>(lds, g, S, E); }
    SEAM(8);
    if (IN(9)) { for (int it = bid; it < 256; it += G) xa_item(it, lds, XQ, XK, XO, tid, wid, lane); }
    SEAM(9);
    if (IN(10)) { pg8::Gemm g{XO, (const bf16_t*)(ws + WS_VWOT), T, 2 * D, 2 * 512}; OutOrder S; S.b.init(T, D, G, bid); EpiResid<false, false> E{nullptr, nullptr, XB, SSQ3, 1.0f};
        pg8::gemm_phase<EpiResid<false, false>, OutOrder, GEMM_ALIGN1, GEMM_SP2>(lds, g, S, E); }
    SEAM(10);
    if (IN(11)) { pg8::Gemm g{XB, W2GU, T, 2 * FF, D}; pg8::StaticOrder S; S.init(T, 2 * FF, G, bid); RS_TABLE(S, SSQ3);
        EpiSwiGLU E{ACT}; pg8::gemm_phase<EpiSwiGLU, pg8::StaticOrder, GEMM_ALIGNM, GEMM_SP2>(lds, g, S, E);
        if (G == 256 && bid >= 128) { __syncthreads(); tr_all(a.in, ws, (LAS float*)(lds + wid * 16640), (bid - 128) * 8 + wid, 128 * 8, lane, TrRanges{21888, 24704, 0, 0, 0, 0}); } }
    SEAM(11);
#ifndef FUSE_FINAL
#define FUSE_FINAL 1
#endif
    const bool fuse_final = FUSE_FINAL && G == 256 && hi_ph - lo > 1;
    if (IN(12)) { pg8::Gemm g{ACT, W2D, T, D, FF}; pg8::StaticOrder S; S.init(T, D, G, bid);
        if (fuse_final) { EpiFinal E{a.out, XB, (float*)(ws + WS_XBUF), (unsigned*)(ws + WS_CTL + 16384), a.in[20], 0.5f}; pg8::gemm_phase<EpiFinal, pg8::StaticOrder, false, GEMM_SP2>(lds, g, S, E); }
        }
    if (!fuse_final) SEAM(12);
#undef IN
#undef SEAM
}

extern "C" void kernel_launch(void* const* d_in, const int* in_sizes, int n_in, void* d_out, int out_size, void* d_ws, size_t ws_size, hipStream_t stream) {
    static int grid = 0;
    if (grid == 0) {
        if (n_in != 21 || ws_size < WS_END) { fprintf(stderr, "kernel_launch: unexpected inputs (n_in %d, ws %zu)\n", n_in, ws_size); grid = -1; return; }
        int dev = 0, cus = 0, per_cu = 0;
        hipGetDevice(&dev); hipDeviceGetAttribute(&cus, hipDeviceAttributeMultiprocessorCount, dev);
        hipFuncSetAttribute((const void*)mk_fwd, hipFuncAttributeMaxDynamicSharedMemorySize, LDS_BYTES);
        hipOccupancyMaxActiveBlocksPerMultiprocessor(&per_cu, (const void*)mk_fwd, 512, LDS_BYTES);
        if (per_cu < 1) { fprintf(stderr, "kernel_launch: occupancy query says %d blocks per CU\n", per_cu); per_cu = 1; }
        (void)hipGetLastError();
        if (cus < 256) { fprintf(stderr, "kernel_launch: built for a 256-CU MI355X (one workgroup per CU), device reports %d CUs; nothing launched\n", cus); grid = -1; return; }
        grid = 256;
    }
    if (grid < 0) return;
    Args a{};
    for (int i = 0; i < 21; ++i) a.in[i] = (const float*)d_in[i];
    a.out = (float*)d_out; a.ws = (unsigned char*)d_ws;
#if MK_SINGLE
    a.ph_lo = 0; a.ph_hi = NPH;
    hipMemsetAsync((unsigned char*)d_ws + WS_CTL, 0, CTL_BYTES, stream);
    void* args[] = {&a};
    hipError_t e = hipLaunchCooperativeKernel((const void*)mk_fwd, dim3(grid), dim3(512), args, LDS_BYTES, stream);
    if (e != hipSuccess) fprintf(stderr, "cooperative launch failed: %s (grid %d)\n", hipGetErrorString(e), grid);
#else
#ifndef FWD_REPS
#define FWD_REPS 1
#endif
    for (int fr_ = 0; fr_ < FWD_REPS; ++fr_)
    for (int p = 0; p < NPH; ++p) { a.ph_lo = p; a.ph_hi = p + 1; const int reps = ((PHREP) == p || ((PHREP) == 456 && p >= 4 && p <= 6)) ? 2 : 1;
        for (int r = 0; r < reps; ++r) { a.sub = r; hipLaunchKernelGGL(mk_fwd, dim3(grid), dim3(512), LDS_BYTES, stream, a); } a.sub = 0; }
#ifdef NOOP_LAUNCHES
    for (int r = 0; r < NOOP_LAUNCHES; ++r) { a.ph_lo = 20; a.ph_hi = 21; hipLaunchKernelGGL(mk_fwd, dim3(grid), dim3(512), LDS_BYTES, stream, a); }
#endif
#endif
}
```

```cpp
#include <hip/hip_runtime.h>
#include <hip/hip_cooperative_groups.h>
#include <cstdio>
#include <cstdint>
namespace cg = cooperative_groups;
#define MK_SINGLE 1
#ifndef PG8_WGM
#define PG8_WGM 8
#endif
#ifndef PG8_ROT
#define PG8_ROT 0
#endif
#ifndef PG8_BAUX
#define PG8_BAUX 0
#endif
namespace pg8 {
#define PG8_LAS __attribute__((address_space(3)))
typedef unsigned short bf16_t;
typedef short bf16x8 __attribute__((ext_vector_type(8)));
typedef float f32x4 __attribute__((ext_vector_type(4)));
typedef unsigned u32x4 __attribute__((ext_vector_type(4)));
constexpr int BM = 256, BK = 64, HALF = 128, HTB = HALF * BK * 2  , STAGE_BYTES = 8 * HTB, NXCD = 8, WGM = PG8_WGM;

__host__ __device__ __forceinline__ int lds_byte(int r, int c) { const int st = (r >> 4) * 2 + (c >> 5), rr = r & 15, cc = c & 31, ob = rr * 64 + cc * 2; return st * 1024 + (ob ^ (((ob >> 9) & 1) << 5)); }
__host__ __device__ __forceinline__ void stage_rc(int b, int& R, int& C) { const int st = b / 1024, sb = b % 1024, swz = sb ^ (((sb >> 9) & 1) << 5); R = (st >> 1) * 16 + swz / 64; C = (st & 1) * 32 + (swz % 64) / 2; }
__host__ __device__ __forceinline__ int perm32(int rho) { const int n = rho >> 4, i = rho & 15; return 8 * (i >> 2) + 4 * n + (i & 3); }

struct Unit { int pm, pn; };
struct Gemm { const bf16_t* A; const bf16_t* Bt; int M, N, K; };

struct StaticOrder {
    int nM, nN, nwg, G, c;
    __host__ __device__ void init(int M, int N, int G_, int c_) { nM = M / BM; nN = N / BM; nwg = nM * nN; G = G_; c = c_; }
    __host__ __device__ bool next(int i, Unit& u) const {
        const long L = (long)i * G + c; if (L >= nwg) return false;
        int wgid = (int)L; { const int q = nwg / NXCD, r = nwg % NXCD, xcd = wgid % NXCD, off = wgid / NXCD; wgid = (xcd < r ? xcd * (q + 1) : r * (q + 1) + (xcd - r) * q) + off; }
        const int nig = WGM * nN, gid = wgid / nig, fm = gid * WGM, gsz = (nM - fm) < WGM ? (nM - fm) : WGM;
        u.pm = fm + ((wgid % nig) % gsz); u.pn = (wgid % nig) / gsz;
#if PG8_ROT
        if (nM == 32 && (nN & 1) == 0 && nN >= 16 && nwg % NXCD == 0) { const int xcd = (int)(L % NXCD), half = nN / 2, base = (xcd & 1) * half; u.pn = base + (u.pn - base + (xcd >> 1) * (half / 4)) % half; }
#endif
        return true;
    }
    __device__ __forceinline__ void a_ready(const Unit&) const {}
    __device__ __forceinline__ void done(const Unit&) const {}
};

template <class Epi, class Sched, bool ALIGN_EPI = false, bool SP2 = false>
__device__ __forceinline__ void gemm_phase(PG8_LAS unsigned char* lds, const Gemm g, const Sched& S, const Epi& E) {
    const int tid = threadIdx.x, wid = __builtin_amdgcn_readfirstlane(tid >> 6), lane = tid & 63, wr = wid >> 2, wc = wid & 3, fr = lane & 15, fq = lane >> 4;
    const int K = g.K, nt = K / BK;
    unsigned voffA[2], voffB[2];
#pragma unroll
    for (int i = 0; i < 2; ++i) { int R, C; stage_rc(tid * 16 + i * 8192, R, C); const int Rb = Epi::PERM ? ((R & ~31) + perm32(R & 31)) : R;
        voffA[i] = (unsigned)(R * K + C) * 2u; voffB[i] = (unsigned)(Rb * K + C) * 2u; }
    const size_t kstep = (size_t)(BK * 2);
    const size_t hstep = (size_t)HALF * K * 2;
    const size_t tstep = 2 * hstep;
    const unsigned ldsw = (unsigned)wid * 1024u;
    const int aoff = lds_byte(wr * 64 + fr, fq * 8), boff = lds_byte(wc * 32 + fr, fq * 8);
#define PG8_SA(b, h) (((b) * 2 + (h)) * HTB)
#define PG8_SB(b, h) ((4 + (b) * 2 + (h)) * HTB)
#define PG8_STAGE(bufoff, gbase, voff) do { _Pragma("unroll") for (int _i = 0; _i < 2; ++_i) \
        __builtin_amdgcn_global_load_lds((const unsigned*)((const char*)(gbase) + (voff)[_i]), (PG8_LAS unsigned*)(lds + (bufoff) + ldsw + _i * 8192), 16, 0, 0); } while (0)
#define PG8_STAGEB(bufoff, gbase, voff) do { _Pragma("unroll") for (int _i = 0; _i < 2; ++_i) \
        __builtin_amdgcn_global_load_lds((const unsigned*)((const char*)(gbase) + (voff)[_i]), (PG8_LAS unsigned*)(lds + (bufoff) + ldsw + _i * 8192), 16, 0, PG8_BAUX); } while (0)
#define PG8_LDA(dst, b, h) do { _Pragma("unroll") for (int m = 0; m < 4; ++m) _Pragma("unroll") for (int k = 0; k < 2; ++k) dst[m][k] = *(const PG8_LAS bf16x8*)(lds + PG8_SA(b, h) + aoff + m * 2048 + k * 1024); } while (0)
#define PG8_LDB(dst, b, h) do { _Pragma("unroll") for (int n = 0; n < 2; ++n) _Pragma("unroll") for (int k = 0; k < 2; ++k) dst[n][k] = *(const PG8_LAS bf16x8*)(lds + PG8_SB(b, h) + boff + n * 2048 + k * 1024); } while (0)
#define PG8_MMA(ai, bj, At, Bt) do { __builtin_amdgcn_s_setprio(1); _Pragma("unroll") for (int m = 0; m < 4; ++m) _Pragma("unroll") for (int n = 0; n < 2; ++n) _Pragma("unroll") for (int k = 0; k < 2; ++k) \
        acc[ai][bj][m][n] = __builtin_amdgcn_mfma_f32_16x16x32_bf16(Bt[n][k], At[m][k], acc[ai][bj][m][n], 0, 0, 0); __builtin_amdgcn_s_setprio(0); } while (0)
#define PG8_WAIT_V(n) asm volatile("s_waitcnt vmcnt(" #n ")" ::: "memory")
#define PG8_WAIT_L(n) asm volatile("s_waitcnt lgkmcnt(" #n ")" ::: "memory")
#define PG8_BAR __builtin_amdgcn_s_barrier()
#define PG8_SCHED __builtin_amdgcn_sched_barrier(0)
    Unit cur, nxt; int ui = 0;
    if (!S.next(0, cur)) return;
    f32x4 acc[2][2][4][2];
#pragma unroll
    for (int a = 0; a < 2; ++a)
#pragma unroll
        for (int b = 0; b < 2; ++b)
#pragma unroll
            for (int m = 0; m < 4; ++m)
#pragma unroll
                for (int n = 0; n < 2; ++n) acc[a][b][m][n] = (f32x4){0.f, 0.f, 0.f, 0.f};
    bf16x8 At[4][2], B0[2][2], B1[2][2];
    const char* cA = (const char*)g.A + (size_t)cur.pm * tstep; const char* cB = (const char*)g.Bt + (size_t)cur.pn * tstep;
    S.a_ready(cur);
    if constexpr (SP2) {
        PG8_STAGEB(PG8_SB(0, 0), cB, voffB); PG8_STAGEB(PG8_SB(0, 1), cB + hstep, voffB); PG8_STAGE(PG8_SA(0, 0), cA, voffA); PG8_STAGE(PG8_SA(0, 1), cA + hstep, voffA);
        if (wr == 1) PG8_BAR;
        PG8_WAIT_V(2); PG8_BAR;
        PG8_STAGEB(PG8_SB(1, 0), cB + kstep, voffB); PG8_STAGE(PG8_SA(1, 0), cA + kstep, voffA); PG8_STAGEB(PG8_SB(1, 1), cB + hstep + kstep, voffB);
        PG8_WAIT_V(6); PG8_BAR;
    } else {
        PG8_STAGEB(PG8_SB(0, 0), cB, voffB); PG8_STAGE(PG8_SA(0, 0), cA, voffA); PG8_STAGEB(PG8_SB(0, 1), cB + hstep, voffB); PG8_STAGE(PG8_SA(0, 1), cA + hstep, voffA);
        if (wr == 1) PG8_BAR;
        PG8_WAIT_V(4); PG8_BAR;
        PG8_STAGEB(PG8_SB(1, 0), cB + kstep, voffB); PG8_STAGE(PG8_SA(1, 0), cA + kstep, voffA); PG8_STAGEB(PG8_SB(1, 1), cB + hstep + kstep, voffB);
        PG8_WAIT_V(6); PG8_BAR;
    }
    for (;;) {
        const bool has_next = S.next(ui + 1, nxt);
        const char* nA = has_next ? (const char*)g.A + (size_t)nxt.pm * tstep : cA; const char* nB = has_next ? (const char*)g.Bt + (size_t)nxt.pn * tstep : cB;
        for (int t = 0; t < nt; t += 2) {
            const bool last = (t == nt - 2);
            const char* a1 = cA + (size_t)(t + 1) * kstep;
            const char* a2 = last ? nA : cA + (size_t)(t + 2) * kstep; const char* b2 = last ? nB : cB + (size_t)(t + 2) * kstep;
            const char* a3 = a2 + kstep; const char* b3 = b2 + kstep;
            if (last && has_next) S.a_ready(nxt);
            if constexpr (SP2) {
            PG8_LDB(B0, 0, 0); PG8_LDB(B1, 0, 1); PG8_SCHED; PG8_LDA(At, 0, 0); PG8_STAGE(PG8_SA(1, 1), a1 + hstep, voffA);
            PG8_WAIT_V(8); PG8_WAIT_L(0); PG8_BAR; PG8_MMA(0, 0, At, B0); PG8_MMA(0, 1, At, B1); PG8_BAR; PG8_SCHED;
            PG8_LDA(At, 0, 1); PG8_STAGEB(PG8_SB(0, 0), b2, voffB); PG8_STAGEB(PG8_SB(0, 1), b2 + hstep, voffB); PG8_STAGE(PG8_SA(0, 0), a2, voffA);
            PG8_WAIT_V(8); PG8_WAIT_L(0); PG8_BAR; PG8_MMA(1, 0, At, B0); PG8_MMA(1, 1, At, B1); PG8_BAR; PG8_SCHED;
            PG8_LDB(B0, 1, 0); PG8_LDB(B1, 1, 1); PG8_SCHED; PG8_LDA(At, 1, 0); PG8_STAGE(PG8_SA(0, 1), a2 + hstep, voffA);
            PG8_WAIT_V(8); PG8_WAIT_L(0); PG8_BAR; PG8_MMA(0, 0, At, B0); PG8_MMA(0, 1, At, B1); PG8_BAR; PG8_SCHED;
            PG8_LDA(At, 1, 1); PG8_STAGEB(PG8_SB(1, 0), b3, voffB); PG8_STAGEB(PG8_SB(1, 1), b3 + hstep, voffB); PG8_STAGE(PG8_SA(1, 0), a3, voffA);
            PG8_WAIT_V(8); PG8_WAIT_L(0); PG8_BAR; PG8_MMA(1, 0, At, B0); PG8_MMA(1, 1, At, B1); PG8_BAR; PG8_SCHED;
            } else {
            PG8_LDB(B0, 0, 0); PG8_SCHED; PG8_LDA(At, 0, 0); PG8_STAGE(PG8_SA(1, 1), a1 + hstep, voffA);
            PG8_WAIT_L(8); PG8_BAR; PG8_WAIT_L(0); PG8_MMA(0, 0, At, B0); PG8_BAR; PG8_SCHED;
            PG8_LDB(B1, 0, 1); PG8_STAGEB(PG8_SB(0, 0), b2, voffB);
            PG8_BAR; PG8_WAIT_L(0); PG8_MMA(0, 1, At, B1); PG8_BAR;
            PG8_LDA(At, 0, 1); PG8_STAGE(PG8_SA(0, 0), a2, voffA);
            PG8_BAR; PG8_WAIT_L(0); PG8_MMA(1, 0, At, B0); PG8_BAR; PG8_SCHED;
            PG8_STAGEB(PG8_SB(0, 1), b2 + hstep, voffB);
            PG8_WAIT_V(6); PG8_BAR; PG8_MMA(1, 1, At, B1); PG8_BAR;
            PG8_LDB(B0, 1, 0); PG8_SCHED; PG8_LDA(At, 1, 0); PG8_STAGE(PG8_SA(0, 1), a2 + hstep, voffA);
            PG8_WAIT_L(8); PG8_BAR; PG8_WAIT_L(0); PG8_MMA(0, 0, At, B0); PG8_BAR; PG8_SCHED;
            PG8_LDB(B1, 1, 1); PG8_STAGEB(PG8_SB(1, 0), b3, voffB);
            PG8_BAR; PG8_WAIT_L(0); PG8_MMA(0, 1, At, B1); PG8_BAR;
            PG8_LDA(At, 1, 1); PG8_STAGE(PG8_SA(1, 0), a3, voffA);
            PG8_BAR; PG8_WAIT_L(0); PG8_MMA(1, 0, At, B0); PG8_BAR; PG8_SCHED;
            PG8_STAGEB(PG8_SB(1, 1), b3 + hstep, voffB);
            PG8_WAIT_V(6); PG8_BAR; PG8_MMA(1, 1, At, B1); PG8_BAR;
            }
        }
        if constexpr (ALIGN_EPI) { if (wr == 0) PG8_BAR; }
        if constexpr (!Epi::AFTER_DRAIN) { E(acc, cur, wr, wc, fr, fq); S.done(cur); }
        if (!has_next) break;
#pragma unroll
        for (int a = 0; a < 2; ++a)
#pragma unroll
            for (int b = 0; b < 2; ++b)
#pragma unroll
                for (int m = 0; m < 4; ++m)
#pragma unroll
                    for (int n = 0; n < 2; ++n) acc[a][b][m][n] = (f32x4){0.f, 0.f, 0.f, 0.f};
        cur = nxt; cA = nA; cB = nB; ++ui;
        if constexpr (ALIGN_EPI) { if (wr == 1) PG8_BAR; }
    }
    PG8_WAIT_V(0);
    if constexpr (!ALIGN_EPI) { if (wr == 0) PG8_BAR; }
    PG8_BAR;
    if constexpr (Epi::AFTER_DRAIN) { E.fused(acc, cur, wr, wc, fr, fq, lds, wid, lane); S.done(cur); }
#undef PG8_SA
#undef PG8_SB
#undef PG8_STAGE
#undef PG8_STAGEB
#undef PG8_LDA
#undef PG8_LDB
#undef PG8_MMA
#undef PG8_WAIT_V
#undef PG8_WAIT_L
#undef PG8_BAR
#undef PG8_SCHED
}
}

using pg8::bf16_t; using pg8::bf16x8; using pg8::f32x4; using pg8::u32x4; using pg8::Unit;
#define LAS __attribute__((address_space(3)))
typedef float f32x16 __attribute__((ext_vector_type(16)));
typedef short s16x4 __attribute__((ext_vector_type(4)));
typedef float f32x2_t __attribute__((ext_vector_type(2)));
typedef __bf16 bf16x2_t __attribute__((ext_vector_type(2)));
typedef unsigned u32x2 __attribute__((ext_vector_type(2)));

constexpr int T = 8192, D = 2048, SEQ = 4096, FF = 5632, INC = 5376, MEMT = 512, MEML = 256;
constexpr float EPS = 1e-6f, LOG2E = 1.4426950408889634f;
constexpr int NPH = 14;
#ifndef GEMM_ALIGNM
#define GEMM_ALIGNM true
#endif
#ifndef STG_NT
#define STG_NT 0
#endif
#ifndef WO_IN_P0
#define WO_IN_P0 1
#endif
#ifndef W2GU_SPLIT
#define W2GU_SPLIT 17792
#endif
#ifndef X_LAST
#define X_LAST 0
#endif
#ifndef P2_BASE_F32
#define P2_BASE_F32 true
#endif
#ifndef GEMM_SP2
#define GEMM_SP2 true
#endif
#ifndef GEMM_ALIGN1
#define GEMM_ALIGN1 true
#endif
#ifndef MK_SINGLE
#define MK_SINGLE 1
#endif

constexpr size_t MiB = 1u << 20;
constexpr size_t WS_SSQX = 262144;
constexpr size_t WS_SSQ0 = 0, WS_SSQ1 = 32768, WS_SSQ2 = 65536, WS_SSQ3 = 98304, WS_SSQ4 = 131072, WS_SSQM = 163840;
constexpr size_t WS_CTL = 196608, CTL_BYTES = 32768, WS_XBUF = 524288;
constexpr int LDS_BAR_OFF = 139264;
constexpr size_t WS_C128 = 1 * MiB, WS_S128 = 2 * MiB, WS_C64 = 3 * MiB, WS_S64 = 3 * MiB + 512 * 1024;
constexpr size_t WS_MEMB = 4 * MiB, WS_XK = 6 * MiB, WS_XVT = 8 * MiB;
constexpr size_t WS_W1GU = 16 * MiB, WS_W1D = 60 * MiB, WS_WIN = 82 * MiB, WS_WOUT = 103 * MiB, WS_WQ = 111 * MiB, WS_WKV = 119 * MiB, WS_WO = 135 * MiB,
                 WS_W2GU = 143 * MiB, WS_W2D = 187 * MiB;
constexpr size_t WS_XB = 209 * MiB, WS_MIX = 241 * MiB, WS_R1 = 273 * MiB, WS_VWOT = 409 * MiB, WS_END = 417 * MiB;
constexpr size_t R1_ACT = 0, R1_RQ = 0, R1_RK = 16 * MiB, R1_RV = 32 * MiB, R1_RG = 48 * MiB, R1_SQ = 64 * MiB, R1_SK = 80 * MiB, R1_SV = 82 * MiB,
                 R1_STATE = 84 * MiB, R1_SPREV = 116 * MiB, R1_XQ = 0, R1_XO = 32 * MiB;
constexpr int LDS_BYTES = 147456;

__device__ __forceinline__ unsigned cvtpk(float lo, float hi) { f32x2_t v = {lo, hi}; bf16x2_t b = __builtin_convertvector(v, bf16x2_t); return __builtin_bit_cast(unsigned, b); }
__device__ __forceinline__ float bf2f(unsigned short b) { return __uint_as_float(((unsigned)b) << 16); }
__device__ __forceinline__ float bflo(unsigned w) { return __uint_as_float(w << 16); }
__device__ __forceinline__ float bfhi(unsigned w) { return __uint_as_float(w & 0xffff0000u); }
__device__ __forceinline__ int crow(int r, int hi) { return (r & 3) + 8 * (r >> 2) + 4 * hi; }
__device__ __forceinline__ float silu_f(float g) { return g * __builtin_amdgcn_rcpf(1.0f + __builtin_amdgcn_exp2f(-g * LOG2E)); }
__device__ __forceinline__ float lg2gamma(int h) { return log2f(1.0f - exp2f(-5.0f - (float)h)); }
__device__ __forceinline__ float wave_sum(float v) {
#pragma unroll
    for (int o = 1; o < 64; o <<= 1) v += __shfl_xor(v, o);
    return v;
}
__device__ __forceinline__ bf16x8 pack8(const f32x16& p, int s) {
    u32x4 w; w.x = cvtpk(p[8 * s + 0], p[8 * s + 1]); w.y = cvtpk(p[8 * s + 2], p[8 * s + 3]); w.z = cvtpk(p[8 * s + 4], p[8 * s + 5]); w.w = cvtpk(p[8 * s + 6], p[8 * s + 7]);
    return __builtin_bit_cast(bf16x8, w);
}
__device__ __forceinline__ bf16x8 lds_cat(const LAS bf16_t* p) {
    const s16x4 a = *(const LAS s16x4*)p, b = *(const LAS s16x4*)(p + 8);
    return __builtin_shufflevector(a, b, 0, 1, 2, 3, 4, 5, 6, 7);
}
__device__ __forceinline__ bf16x8 g_cat(const bf16_t* p) {
    const s16x4 a = *(const s16x4*)p, b = *(const s16x4*)(p + 8);
    return __builtin_shufflevector(a, b, 0, 1, 2, 3, 4, 5, 6, 7);
}
#ifndef WT_STORES
#define WT_STORES 0
#endif
#ifndef EPI_NT
#define EPI_NT 0
#endif
#ifndef ACT_NT
#define ACT_NT 0
#endif
__device__ __forceinline__ void st16(void* p, u32x4 v) {
#if WT_STORES
    asm volatile("global_store_dwordx4 %0, %1, off sc0 sc1" :: "v"(p), "v"(v) : "memory");
#elif EPI_NT
    __builtin_nontemporal_store(v, (u32x4*)p);
#else
    *(u32x4*)p = v;
#endif
}
#define MFMA32(a, b, c) __builtin_amdgcn_mfma_f32_32x32x16_bf16((a), (b), (c), 0, 0, 0)

struct EpiSwiGLU {
    static constexpr bool PERM = true, AFTER_DRAIN = false;
    bf16_t* O;
    __device__ __forceinline__ void operator()(const f32x4 (&acc)[2][2][4][2], const Unit& u, int wr, int wc, int fr, int fq) const {
        const int row0 = u.pm * 256 + wr * 64 + fr, col0 = u.pn * 128 + wc * 32 + 8 * fq;
#pragma unroll
        for (int ai = 0; ai < 2; ++ai)
#pragma unroll
            for (int m = 0; m < 4; ++m) {
                const int row = row0 + ai * 128 + m * 16;
                const float rs = ((const LAS float*)131072)[wr * 64 + fr + ai * 128 + m * 16];
                const float c1 = -rs * LOG2E, c2 = rs * rs;
                float o[8];
#pragma unroll
                for (int n = 0; n < 2; ++n)
#pragma unroll
                    for (int e = 0; e < 4; e += 2) {
                        const f32x2_t g = {acc[ai][0][m][n][e], acc[ai][0][m][n][e + 1]}, up = {acc[ai][1][m][n][e], acc[ai][1][m][n][e + 1]};
                        const f32x2_t t = g * c1; f32x2_t ex; ex.x = __builtin_amdgcn_exp2f(t.x); ex.y = __builtin_amdgcn_exp2f(t.y);
                        const f32x2_t d = ex + 1.0f; f32x2_t sg; sg.x = __builtin_amdgcn_rcpf(d.x); sg.y = __builtin_amdgcn_rcpf(d.y);
                        const f32x2_t r = (g * up) * (sg * c2);
                        o[4 * n + e] = r.x; o[4 * n + e + 1] = r.y;
                    }
                u32x4 w; w.x = cvtpk(o[0], o[1]); w.y = cvtpk(o[2], o[3]); w.z = cvtpk(o[4], o[5]); w.w = cvtpk(o[6], o[7]);
                if (ACT_NT) __builtin_nontemporal_store(w, (u32x4*)(O + (size_t)row * FF + col0)); else st16(O + (size_t)row * FF + col0, w);
            }
    }
};
template <bool BASE_F32, bool OUT_F32> struct EpiResid {
    static constexpr bool PERM = true, AFTER_DRAIN = false;
    const float* base; float* out; bf16_t* xb; float* ssq_out; float scale;
    __device__ __forceinline__ void operator()(const f32x4 (&acc)[2][2][4][2], const Unit& u, int wr, int wc, int fr, int fq) const {
        const int row0 = u.pm * 256 + wr * 64 + fr, col0 = (u.pn & 7) * 256 + wc * 32 + 8 * fq;
#pragma unroll
        for (int ai = 0; ai < 2; ++ai)
#pragma unroll
            for (int m = 0; m < 4; ++m) {
                const int row = row0 + ai * 128 + m * 16; float s = 0.f;
#pragma unroll
                for (int bj = 0; bj < 2; ++bj) {
                    const size_t off = (size_t)row * D + col0 + bj * 128;
                    f32x4 b0, b1;
                    if (BASE_F32) { b0 = __builtin_nontemporal_load((const f32x4*)(base + off)); b1 = __builtin_nontemporal_load((const f32x4*)(base + off + 4)); }
                    else { const u32x4 w = *(const u32x4*)(xb + off); b0 = (f32x4){bflo(w.x), bfhi(w.x), bflo(w.y), bfhi(w.y)}; b1 = (f32x4){bflo(w.z), bfhi(w.z), bflo(w.w), bfhi(w.w)}; }
                    const f32x4 h0 = b0 + acc[ai][bj][m][0] * scale, h1 = b1 + acc[ai][bj][m][1] * scale;
                    if (OUT_F32) { *(f32x4*)(out + off) = h0; *(f32x4*)(out + off + 4) = h1; }
                    else { u32x4 w; w.x = cvtpk(h0[0], h0[1]); w.y = cvtpk(h0[2], h0[3]); w.z = cvtpk(h1[0], h1[1]); w.w = cvtpk(h1[2], h1[3]); st16(xb + off, w); }
                    s += (h0[0] * h0[0] + h0[1] * h0[1]) + (h0[2] * h0[2] + h0[3] * h0[3]) + (h1[0] * h1[0] + h1[1] * h1[1]) + (h1[2] * h1[2] + h1[3] * h1[3]);
                }
                s += __shfl_xor(s, 16); s += __shfl_xor(s, 32);
                if (fq == 0) __hip_atomic_fetch_add(ssq_out + row, s, __ATOMIC_RELAXED, __HIP_MEMORY_SCOPE_AGENT);
            }
    }
};
struct EpiFinal {
    static constexpr bool PERM = true, AFTER_DRAIN = true;
    float* out; const bf16_t* xb; float* xbuf; unsigned* cnt; const float* gain; float scale;
    __device__ __forceinline__ void fused(f32x4 (&acc)[2][2][4][2], const Unit& u, int wr, int wc, int fr, int fq, PG8_LAS unsigned char* lds, int wid, int lane) const {
        LAS float* P = (LAS float*)lds;
        LAS float* S = (LAS float*)(lds + 4096);
        const int col0 = u.pn * 256 + wc * 32 + 8 * fq;
#pragma unroll
        for (int ai = 0; ai < 2; ++ai)
#pragma unroll
            for (int m = 0; m < 4; ++m) {
                const int rl = ai * 128 + wr * 64 + m * 16 + fr; float s = 0.f;
#pragma unroll
                for (int bj = 0; bj < 2; ++bj) {
                    const size_t off = (size_t)(u.pm * 256 + rl) * D + col0 + bj * 128;
                    const u32x4 w = *(const u32x4*)(xb + off);
                    const f32x4 b0 = (f32x4){bflo(w.x), bfhi(w.x), bflo(w.y), bfhi(w.y)}, b1 = (f32x4){bflo(w.z), bfhi(w.z), bflo(w.w), bfhi(w.w)};
                    const f32x4 h0 = b0 + acc[ai][bj][m][0] * scale, h1 = b1 + acc[ai][bj][m][1] * scale;
                    acc[ai][bj][m][0] = h0; acc[ai][bj][m][1] = h1;
                    s += (h0[0] * h0[0] + h0[1] * h0[1]) + (h0[2] * h0[2] + h0[3] * h0[3]) + (h1[0] * h1[0] + h1[1] * h1[1]) + (h1[2] * h1[2] + h1[3] * h1[3]);
                }
                s += __shfl_xor(s, 16); s += __shfl_xor(s, 32);
                if (fq == 0) P[rl * 4 + wc] = s;
            }
        asm volatile("s_waitcnt lgkmcnt(0)" ::: "memory"); __builtin_amdgcn_s_barrier(); asm volatile("" ::: "memory");
        const int row = wid * 32 + (lane & 31);
        if (lane < 32) {
            const float t = (P[row * 4 + 0] + P[row * 4 + 1]) + (P[row * 4 + 2] + P[row * 4 + 3]);
            __hip_atomic_store(xbuf + (size_t)(u.pm * 256 + row) * 8 + u.pn, t, __ATOMIC_RELAXED, __HIP_MEMORY_SCOPE_AGENT);
        }
        asm volatile("s_waitcnt vmcnt(0)" ::: "memory");
        unsigned* c = cnt + 64 * u.pm;
        if (lane == 0) __hip_atomic_fetch_add(c, 1u, __ATOMIC_RELAXED, __HIP_MEMORY_SCOPE_AGENT);
        if (wid == 0) {
            unsigned sp = 0;
            while ((unsigned)__builtin_amdgcn_readfirstlane(__hip_atomic_load(c, __ATOMIC_RELAXED, __HIP_MEMORY_SCOPE_AGENT)) < 64u) { __builtin_amdgcn_s_sleep(2); if (++sp > (1u << 22)) break; }
            __builtin_amdgcn_fence(__ATOMIC_ACQUIRE, "agent");
        }
        asm volatile("s_waitcnt vmcnt(0) lgkmcnt(0)" ::: "memory"); __builtin_amdgcn_s_barrier(); asm volatile("" ::: "memory");
        if (lane < 32) {
            const float* slot = xbuf + (size_t)(u.pm * 256 + row) * 8; float t = 0.f;
#pragma unroll
            for (int k = 0; k < 8; ++k) t += __hip_atomic_load(slot + k, __ATOMIC_RELAXED, __HIP_MEMORY_SCOPE_AGENT);
            S[row] = rsqrtf(t * (1.0f / D) + EPS);
        }
        asm volatile("s_waitcnt vmcnt(0) lgkmcnt(0)" ::: "memory"); __builtin_amdgcn_s_barrier(); asm volatile("" ::: "memory");
        f32x4 g[2][2];
#pragma unroll
        for (int bj = 0; bj < 2; ++bj) { g[bj][0] = *(const f32x4*)(gain + col0 + bj * 128); g[bj][1] = *(const f32x4*)(gain + col0 + bj * 128 + 4); }
#pragma unroll
        for (int ai = 0; ai < 2; ++ai)
#pragma unroll
            for (int m = 0; m < 4; ++m) {
                const int rl = ai * 128 + wr * 64 + m * 16 + fr; const float rs = S[rl];
#pragma unroll
                for (int bj = 0; bj < 2; ++bj) {
                    const size_t off = (size_t)(u.pm * 256 + rl) * D + col0 + bj * 128;
                    *(f32x4*)(out + off) = acc[ai][bj][m][0] * rs * g[bj][0]; *(f32x4*)(out + off + 4) = acc[ai][bj][m][1] * rs * g[bj][1];
                }
            }
    }
};
struct EpiVWo {
    static constexpr bool PERM = true, AFTER_DRAIN = false;
    bf16_t* VWOT;
    __device__ __forceinline__ void operator()(const f32x4 (&acc)[2][2][4][2], const Unit& u, int wr, int wc, int fr, int fq) const {
        const int row0 = u.pm * 256 + wr * 64 + fr, col0 = u.pn * 256 + wc * 32 + 8 * fq;
#pragma unroll
        for (int ai = 0; ai < 2; ++ai)
#pragma unroll
            for (int m = 0; m < 4; ++m) {
                const int row = row0 + ai * 128 + m * 16, n = row & 2047;
#pragma unroll
                for (int bj = 0; bj < 2; ++bj) {
                    const int c = col0 + bj * 128, b = c >> 10, hm = c & 1023;
                    const f32x4 v0 = acc[ai][bj][m][0], v1 = acc[ai][bj][m][1];
                    u32x4 w; w.x = cvtpk(v0[0], v0[1]); w.y = cvtpk(v0[2], v0[3]); w.z = cvtpk(v1[0], v1[1]); w.w = cvtpk(v1[2], v1[3]);
                    *(u32x4*)(VWOT + ((size_t)(b * 2048 + n)) * 1024 + hm) = w;
                }
            }
    }
};
struct VwoOrder {
    int idx;
    __device__ __forceinline__ bool next(int i, Unit& u) const { if (i != 0 || idx < 0 || idx >= 64) return false; const int h = idx >> 4, b = (idx >> 3) & 1; u.pm = h * 8 + (idx & 7); u.pn = b * 4 + h; return true; }
    __device__ __forceinline__ void a_ready(const Unit&) const {}
    __device__ __forceinline__ void done(const Unit&) const {}
};
struct OutOrder {
    pg8::StaticOrder b;
    __device__ __forceinline__ bool next(int i, Unit& u) const { if (!b.next(i, u)) return false; u.pn += 8 * (u.pm >> 4); return true; }
    __device__ __forceinline__ void a_ready(const Unit&) const {}
    __device__ __forceinline__ void done(const Unit&) const {}
};
struct EpiScale {
    static constexpr bool PERM = true, AFTER_DRAIN = false;
    bf16_t* O; const float* ssq; float cs;
    __device__ __forceinline__ void operator()(const f32x4 (&acc)[2][2][4][2], const Unit& u, int wr, int wc, int fr, int fq) const {
        const int row0 = u.pm * 256 + wr * 64 + fr, col0 = u.pn * 256 + wc * 32 + 8 * fq;
#pragma unroll
        for (int ai = 0; ai < 2; ++ai)
#pragma unroll
            for (int m = 0; m < 4; ++m) {
                const int row = row0 + ai * 128 + m * 16;
                const float rs = ((const LAS float*)131072)[wr * 64 + fr + ai * 128 + m * 16] * cs;
#pragma unroll
                for (int bj = 0; bj < 2; ++bj) {
                    const f32x4 v0 = acc[ai][bj][m][0] * rs, v1 = acc[ai][bj][m][1] * rs;
                    u32x4 w; w.x = cvtpk(v0[0], v0[1]); w.y = cvtpk(v0[2], v0[3]); w.z = cvtpk(v1[0], v1[1]); w.w = cvtpk(v1[2], v1[3]);
                    st16(O + (size_t)row * D + col0 + bj * 128, w);
                }
            }
    }
};
struct EpiKV {
    static constexpr bool PERM = true, AFTER_DRAIN = false;
    bf16_t* XK; bf16_t* XVT; const float* ssq;
    __device__ __forceinline__ void operator()(const f32x4 (&acc)[2][2][4][2], const Unit& u, int wr, int wc, int fr, int fq) const {
        const int row0 = u.pm * 256 + wr * 64 + fr, col0 = u.pn * 256 + wc * 32 + 8 * fq;
#pragma unroll
        for (int ai = 0; ai < 2; ++ai)
#pragma unroll
            for (int m = 0; m < 4; ++m) {
                const int row = row0 + ai * 128 + m * 16;
                const float rs = rsqrtf(ssq[row] * (1.0f / D) + EPS);
#pragma unroll
                for (int bj = 0; bj < 2; ++bj) {
                    const f32x4 v0 = acc[ai][bj][m][0] * rs, v1 = acc[ai][bj][m][1] * rs;
                    const int c = col0 + bj * 128;
                    if (u.pn < 8) {
                        u32x4 w; w.x = cvtpk(v0[0], v0[1]); w.y = cvtpk(v0[2], v0[3]); w.z = cvtpk(v1[0], v1[1]); w.w = cvtpk(v1[2], v1[3]);
                        *(u32x4*)(XK + (size_t)row * D + c) = w;
                    } else {
                        const int cv = c - D;
                        u32x4 w; w.x = cvtpk(v0[0], v0[1]); w.y = cvtpk(v0[2], v0[3]); w.z = cvtpk(v1[0], v1[1]); w.w = cvtpk(v1[2], v1[3]);
                        *(u32x4*)(XVT + ((size_t)(((row >> 8) * 4 + (cv >> 9)) * MEML + (row & 255))) * 512 + (cv & 511)) = w;
                    }
                }
            }
    }
};
struct EpiWin {
    static constexpr bool PERM = true, AFTER_DRAIN = false;
    const float* ssq; bf16_t *RQ, *RK, *RV, *RG, *SQ, *SK, *SV; const float *C128, *S128, *C64, *S64;
    __device__ __forceinline__ void operator()(const f32x4 (&acc)[2][2][4][2], const Unit& u, int wr, int wc, int fr, int fq) const {
        const int row0 = u.pm * 256 + wr * 64 + fr, pn = u.pn;
#pragma unroll
        for (int ai = 0; ai < 2; ++ai)
#pragma unroll
            for (int m = 0; m < 4; ++m) {
                const int row = row0 + ai * 128 + m * 16, pos = row & (SEQ - 1), cp = row & 127;
                const float rs = ((const LAS float*)131072)[wr * 64 + fr + ai * 128 + m * 16];
                float a[8], b[8];
#pragma unroll
                for (int n = 0; n < 2; ++n)
#pragma unroll
                    for (int e = 0; e < 4; ++e) { a[4 * n + e] = acc[ai][0][m][n][e] * rs; b[4 * n + e] = acc[ai][1][m][n][e] * rs; }
                const bool rope128 = pn < 8, rope64 = (pn >= 16 && pn < 20) || (pn == 20 && wc < 2);
                if (rope128 || rope64) {
                    float cs[8], sn[8]; float sc; bf16_t* dst; int half;
                    if (rope128) {
                        const int sec = pn >> 2, h = 2 * (pn & 3) + (wc >> 1), i0 = (wc & 1) * 32 + 8 * fq;
                        const f32x4 c0 = *(const f32x4*)(C128 + pos * 64 + i0), c1 = *(const f32x4*)(C128 + pos * 64 + i0 + 4);
                        const f32x4 s0 = *(const f32x4*)(S128 + pos * 64 + i0), s1 = *(const f32x4*)(S128 + pos * 64 + i0 + 4);
#pragma unroll
                        for (int e = 0; e < 4; ++e) { cs[e] = c0[e]; cs[4 + e] = c1[e]; sn[e] = s0[e]; sn[4 + e] = s1[e]; }
                        const float lg = lg2gamma(h);
                        sc = sec == 0 ? exp2f((float)cp * lg) : exp2f(-(float)cp * lg) * 0.08838834764831845f;
                        dst = (sec == 0 ? RQ : RK) + (size_t)row * 1024 + h * 128 + i0; half = 64;
                    } else {
                        const int i0 = 8 * fq;
                        const f32x4 c0 = *(const f32x4*)(C64 + pos * 32 + i0), c1 = *(const f32x4*)(C64 + pos * 32 + i0 + 4);
                        const f32x4 s0 = *(const f32x4*)(S64 + pos * 32 + i0), s1 = *(const f32x4*)(S64 + pos * 32 + i0 + 4);
#pragma unroll
                        for (int e = 0; e < 4; ++e) { cs[e] = c0[e]; cs[4 + e] = c1[e]; sn[e] = s0[e]; sn[4 + e] = s1[e]; }
                        if (pn < 20) { sc = 0.125f * LOG2E; dst = SQ + (size_t)row * 1024 + (4 * (pn - 16) + wc) * 64 + i0; }
                        else { sc = 1.0f; dst = SK + (size_t)row * 128 + wc * 64 + i0; }
                        half = 32;
                    }
                    float x1[8], x2[8];
#pragma unroll
                    for (int e = 0; e < 8; ++e) { x1[e] = (a[e] * cs[e] - b[e] * sn[e]) * sc; x2[e] = (b[e] * cs[e] + a[e] * sn[e]) * sc; }
                    u32x4 w1, w2;
                    w1.x = cvtpk(x1[0], x1[1]); w1.y = cvtpk(x1[2], x1[3]); w1.z = cvtpk(x1[4], x1[5]); w1.w = cvtpk(x1[6], x1[7]);
                    w2.x = cvtpk(x2[0], x2[1]); w2.y = cvtpk(x2[2], x2[3]); w2.z = cvtpk(x2[4], x2[5]); w2.w = cvtpk(x2[6], x2[7]);
                    st16(dst, w1); st16(dst + half, w2);
                } else {
                    bf16_t *d0, *d1;
                    if (pn < 12) { d0 = RV + (size_t)row * 1024 + (pn - 8) * 256 + wc * 32 + 8 * fq; d1 = d0 + 128; }
                    else if (pn < 16) {
                        d0 = RG + (size_t)row * 1024 + (pn - 12) * 256 + wc * 32 + 8 * fq; d1 = d0 + 128;
#pragma unroll
                        for (int e = 0; e < 8; ++e) { a[e] = silu_f(a[e]); b[e] = silu_f(b[e]); }
                    } else { d0 = SV + (size_t)row * 128 + (wc - 2) * 32 + 8 * fq; d1 = d0 + 64; }
                    u32x4 w1, w2;
                    w1.x = cvtpk(a[0], a[1]); w1.y = cvtpk(a[2], a[3]); w1.z = cvtpk(a[4], a[5]); w1.w = cvtpk(a[6], a[7]);
                    w2.x = cvtpk(b[0], b[1]); w2.y = cvtpk(b[2], b[3]); w2.z = cvtpk(b[4], b[5]); w2.w = cvtpk(b[6], b[7]);
                    st16(d0, w1); st16(d1, w2);
                }
            }
    }
};

__device__ __forceinline__ int win_src(int d) {
    const int pn = d >> 8, bj = (d >> 7) & 1, o = d & 127;
    if (pn < 8) { const int sec = pn >> 2, pl = pn & 3; return sec * 1024 + (2 * pl + (o >> 6)) * 128 + bj * 64 + (o & 63); }
    if (pn < 16) return d;
    if (pn < 20) { const int pl = pn - 16; return 4096 + (4 * pl + (o >> 5)) * 64 + bj * 32 + (o & 31); }
    if (o < 64) return 5120 + (o >> 5) * 64 + bj * 32 + (o & 31);
    return 5248 + bj * 64 + (o - 64);
}
#ifndef TR_NT
#define TR_NT 1
#endif
#ifndef TR_NTS
#define TR_NTS 1
#endif
#if TR_NT
#define TR_LOAD(p) __builtin_nontemporal_load(p)
#else
#define TR_LOAD(p) (*(p))
#endif
constexpr int TR_NIT = 5632 + 2816 + 2688 + 1024 + 1024 + 2048 + 1024 + 5632 + 2816;
struct TrItem { const float* src; const float* gain; bf16_t* dst; int N, K; bool nts; };
__device__ __forceinline__ TrItem tr_decode(int it, const float* const* in, unsigned char* ws, int lane) {
    int r = it, kind = 0, ndb = 32, N = D, K = D; const float *W, *W2 = nullptr, *gain = nullptr; bf16_t* WT; bool nts = false, woh = false;
    if (r < 5632) { kind = 1; W = in[3]; W2 = in[4]; N = FF; ndb = 176; gain = in[2]; WT = (bf16_t*)(ws + WS_W1GU); }
    else if ((r -= 5632) < 2816) { W = in[5]; K = FF; WT = (bf16_t*)(ws + WS_W1D); }
    else if ((r -= 2816) < 2688) { kind = 2; W = in[7]; N = INC; ndb = 84; gain = in[6]; WT = (bf16_t*)(ws + WS_WIN); nts = true; }
    else if ((r -= 2688) < 1024) { W = in[10]; WT = (bf16_t*)(ws + WS_WOUT); nts = true; }
    else if ((r -= 1024) < 1024) { W = in[13]; gain = in[11]; WT = (bf16_t*)(ws + WS_WQ); nts = true; }
    else if ((r -= 1024) < 2048) { W = in[14]; N = 2 * D; ndb = 64; gain = in[12]; WT = (bf16_t*)(ws + WS_WKV); }
    else if ((r -= 2048) < 1024) { W = in[15]; WT = (bf16_t*)(ws + WS_WO); nts = true; woh = true; }
    else if ((r -= 1024) < 5632) { kind = 1; W = in[17]; W2 = in[18]; N = FF; ndb = 176; gain = in[16]; WT = (bf16_t*)(ws + WS_W2GU); nts = true; }
    else { r -= 5632; W = in[19]; K = FF; WT = (bf16_t*)(ws + WS_W2D); }
#ifndef TR_ORDER
#define TR_ORDER 1
#endif
#if TR_ORDER >= 1
    constexpr int KL = TR_ORDER, DL = 3 - TR_ORDER;
    const int rh = r >> 3, rl = r & 7, nq = ndb >> DL, kbh = rh / nq, dbh = rh - kbh * nq;
    const int kb = (kbh << KL) + (rl >> DL), db = (dbh << DL) + (rl & ((1 << DL) - 1)), d0 = db * 64, k0 = kb * 64;
#else
    const int kb = r / ndb, db = r - kb * ndb, d0 = db * 64, k0 = kb * 64;
#endif
    const int blk = d0 + 32 * ((lane & 15) >> 3);
    const float* src = W; int s0 = blk;
    if (kind == 1) { const int pn = blk >> 8, bj = (blk >> 7) & 1, o = blk & 127; src = bj ? W2 : W; s0 = pn * 128 + o; }
    else if (kind == 2) s0 = win_src(blk);
    TrItem t; t.src = src + (size_t)(k0 + (lane >> 4)) * N + s0 + 4 * (lane & 7); t.gain = gain ? gain + k0 + 8 * (lane & 7) : nullptr;
    t.dst = WT + (size_t)(d0 + (lane >> 3)) * K + k0 + 8 * (lane & 7); t.N = N; t.K = K; t.nts = nts && TR_NTS;
    if (woh) { t.dst = WT + ((size_t)((k0 >> 9) * 2048 + d0 + (lane >> 3))) * 512 + (k0 & 511) + 8 * (lane & 7); t.K = 512; }
    return t;
}
struct TrRanges { int b0, e0, b1, e1, b2, e2;
    __device__ __forceinline__ int count() const { return (e0 - b0) + (e1 - b1) + (e2 - b2); }
    __device__ __forceinline__ int item(int v) const { const int l0 = e0 - b0, l1 = e1 - b1; return v < l0 ? b0 + v : (v < l0 + l1 ? b1 + (v - l0) : b2 + (v - l0 - l1)); } };
__device__ __forceinline__ void tr_all(const float* const* in, unsigned char* ws, LAS float* scr, int gw, int ngw, int lane, const TrRanges rg) {
    const int TR_CNT = rg.count();
    if (gw >= TR_CNT) return;
    TrItem cur = tr_decode(rg.item(gw), in, ws, lane);
    f32x4 v[16];
#pragma unroll
    for (int i = 0; i < 16; ++i) v[i] = TR_LOAD((const f32x4*)(cur.src + (size_t)(4 * i) * cur.N));
    for (int it = gw; it < TR_CNT; it += ngw) {
        const int nit = it + ngw; const bool hn = nit < TR_CNT;
        TrItem nx = cur; f32x4 w[16];
        if (hn) { nx = tr_decode(rg.item(nit), in, ws, lane);
#pragma unroll
            for (int i = 0; i < 16; ++i) w[i] = TR_LOAD((const f32x4*)(nx.src + (size_t)(4 * i) * nx.N)); }
        LAS float* wp = scr + (lane >> 4) * 65 + 4 * (lane & 15);
#pragma unroll
        for (int i = 0; i < 16; ++i) { wp[(4 * i) * 65 + 0] = v[i][0]; wp[(4 * i) * 65 + 1] = v[i][1]; wp[(4 * i) * 65 + 2] = v[i][2]; wp[(4 * i) * 65 + 3] = v[i][3]; }
        f32x4 g0 = {1.f, 1.f, 1.f, 1.f}, g1 = {1.f, 1.f, 1.f, 1.f};
        if (cur.gain) { g0 = *(const f32x4*)cur.gain; g1 = *(const f32x4*)(cur.gain + 4); }
        asm volatile("s_waitcnt lgkmcnt(0)" ::: "memory");
        const LAS float* rp = scr + (8 * (lane & 7)) * 65 + (lane >> 3);
#pragma unroll
        for (int j = 0; j < 8; ++j) { const LAS float* s = rp + 8 * j;
            u32x4 o; o.x = cvtpk(s[0 * 65] * g0[0], s[1 * 65] * g0[1]); o.y = cvtpk(s[2 * 65] * g0[2], s[3 * 65] * g0[3]);
            o.z = cvtpk(s[4 * 65] * g1[0], s[5 * 65] * g1[1]); o.w = cvtpk(s[6 * 65] * g1[2], s[7 * 65] * g1[3]);
            if (cur.nts) __builtin_nontemporal_store(o, (u32x4*)(cur.dst + (size_t)(8 * j) * cur.K)); else *(u32x4*)(cur.dst + (size_t)(8 * j) * cur.K) = o; }
        asm volatile("s_waitcnt lgkmcnt(0)" ::: "memory");
        if (hn) {
#pragma unroll
            for (int i = 0; i < 16; ++i) v[i] = w[i];
            cur = nx; }
    }
}
__device__ __forceinline__ void row_to_bf16(const float* xrow, bf16_t* orow, float* ssq, int lane) {
    float s = 0.f;
#pragma unroll
    for (int j = 0; j < 8; ++j) { const f32x4 v = *((const f32x4*)xrow + lane + 64 * j); s += (v[0] * v[0] + v[1] * v[1]) + (v[2] * v[2] + v[3] * v[3]);
        u32x2 w; w.x = cvtpk(v[0], v[1]); w.y = cvtpk(v[2], v[3]); *((u32x2*)orow + lane + 64 * j) = w; }
    s = wave_sum(s);
    if (lane == 0) *ssq = s;
}

template <int NR>
__device__ __forceinline__ void rows_to_bf16(const float* x, bf16_t* xb, float* ssq, int r, int stride, int nrows, int lane) {
    f32x4 v[NR][8];
#pragma unroll
    for (int k = 0; k < NR; ++k) { const int rr = r + k * stride; if (rr < nrows) {
#pragma unroll
        for (int j = 0; j < 8; ++j) v[k][j] = __builtin_nontemporal_load((const f32x4*)(x + (size_t)rr * D) + lane + 64 * j); } }
#pragma unroll
    for (int k = 0; k < NR; ++k) { const int rr = r + k * stride; if (rr < nrows) {
        float s = 0.f;
#pragma unroll
        for (int j = 0; j < 8; ++j) { const f32x4 t = v[k][j]; s += (t[0] * t[0] + t[1] * t[1]) + (t[2] * t[2] + t[3] * t[3]);
            u32x2 w; w.x = cvtpk(t[0], t[1]); w.y = cvtpk(t[2], t[3]); *((u32x2*)(xb + (size_t)rr * D) + lane + 64 * j) = w; }
        s = wave_sum(s);
        if (lane == 0) ssq[rr] = s; } }
}

__device__ __forceinline__ int swzc(int c, int j) { return j ^ (((c >> 3) & 15) << 3); }
template <int NROWS, int NCOLS, int VS>
__device__ __forceinline__ void stage_T(LAS bf16_t* dstT, const bf16_t* src, long r0, int ld, int col0, long rmin, int tid) {
    constexpr int NCH = NCOLS / 8, TOT = NROWS * NCH;
#pragma unroll
    for (int i = 0; i < TOT / 512; ++i) {
        const int idx = tid + 512 * i;
        int ch, j;
        if (NCH == 16) { ch = (idx & 7) + 8 * ((idx >> 6) & 1); j = ((idx >> 3) & 7) + 8 * (idx >> 7); } else { ch = idx & 7; j = idx >> 3; }
        const long r = r0 + j;
        u32x4 v = {0u, 0u, 0u, 0u};
        if (r >= rmin) v = STG_NT ? __builtin_nontemporal_load((const u32x4*)(src + r * ld + col0 + 8 * ch)) : *(const u32x4*)(src + r * ld + col0 + 8 * ch);
        LAS bf16_t* d = dstT + (8 * ch) * VS + (j ^ ((ch & 15) << 3));
        d[0 * VS] = (bf16_t)(v.x & 0xffffu); d[1 * VS] = (bf16_t)(v.x >> 16); d[2 * VS] = (bf16_t)(v.y & 0xffffu); d[3 * VS] = (bf16_t)(v.y >> 16);
        d[4 * VS] = (bf16_t)(v.z & 0xffffu); d[5 * VS] = (bf16_t)(v.z >> 16); d[6 * VS] = (bf16_t)(v.w & 0xffffu); d[7 * VS] = (bf16_t)(v.w >> 16);
    }
}
template <int VS>
__device__ __forceinline__ bf16x8 lds_cat_sw(const LAS bf16_t* base, int dd, int c0) {
    const LAS bf16_t* rp = base + dd * VS;
    const s16x4 a = *(const LAS s16x4*)(rp + swzc(dd, c0)), b = *(const LAS s16x4*)(rp + swzc(dd, c0 + 8));
    return __builtin_shufflevector(a, b, 0, 1, 2, 3, 4, 5, 6, 7);
}

__device__ __forceinline__ void swa_item(int it, LAS unsigned char* lds, const bf16_t* SQ, const bf16_t* SK, const bf16_t* SV, const float* sinks, bf16_t* MIX, int tid, int wid, int lane) {
    const int hh = it & 1, kvh = (it >> 1) & 1, n = (it >> 2) & 31, b = it >> 7;
    constexpr int VS = 264;
    LAS bf16_t* VT = (LAS bf16_t*)lds;
    const long rb = (long)b * SEQ; const int pos0 = n * 128;
    __syncthreads();
    stage_T<256, 64, VS>(VT, SV, rb + pos0 - 128, 128, kvh * 64, rb, tid);
    __syncthreads();
    const int x = lane & 31, hi = lane >> 5;
#pragma unroll 1
    for (int tk = wid; tk < 16; tk += 8) {
        const int hl = tk >> 2, qt = tk & 3, head = kvh * 8 + hh * 4 + hl;
        const long qrow = rb + pos0 + 32 * qt + x;
        bf16x8 qf[4];
#pragma unroll
        for (int ks = 0; ks < 4; ++ks) qf[ks] = *(const bf16x8*)(SQ + qrow * 1024 + head * 64 + 16 * ks + 8 * hi);
        f32x16 st[5];
#pragma unroll
        for (int t = 0; t < 5; ++t) {
            int kp = pos0 + 32 * qt - 128 + 32 * t + x; if (kp < 0) kp = 0;
            const bf16_t* kptr = SK + (rb + kp) * 128 + kvh * 64 + 8 * hi;
            f32x16 acc = {};
#pragma unroll
            for (int ks = 0; ks < 4; ++ks) acc = MFMA32(*(const bf16x8*)(kptr + 16 * ks), qf[ks], acc);
            st[t] = acc;
        }
        const float sink2 = sinks[head] * LOG2E;
        float mx = sink2;
#pragma unroll
        for (int r = 0; r < 16; ++r) { const int kk = crow(r, hi); if (kk <= x || (n == 0)) st[0][r] = -1e30f; if (kk > x) st[4][r] = -1e30f; }
#pragma unroll
        for (int t = 1; t < 4; ++t) if (n == 0 && qt + t < 4) {
#pragma unroll
            for (int r = 0; r < 16; ++r) st[t][r] = -1e30f; }
#pragma unroll
        for (int t = 0; t < 5; ++t)
#pragma unroll
            for (int r = 0; r < 16; ++r) mx = fmaxf(mx, st[t][r]);
        mx = fmaxf(mx, __shfl_xor(mx, 32));
        float sum = 0.f;
#pragma unroll
        for (int t = 0; t < 5; ++t)
#pragma unroll
            for (int r = 0; r < 16; ++r) { const float p = __builtin_amdgcn_exp2f(st[t][r] - mx); st[t][r] = p; sum += p; }
        sum += __shfl_xor(sum, 32); sum += __builtin_amdgcn_exp2f(sink2 - mx);
        const float inv = 1.0f / sum;
        f32x16 o0 = {}, o1 = {};
#pragma unroll
        for (int t = 0; t < 5; ++t)
#pragma unroll
            for (int s = 0; s < 2; ++s) {
                const bf16x8 pb = pack8(st[t], s);
                const int c0 = 32 * (qt + t) + 16 * s + 4 * hi;
                o0 = MFMA32(lds_cat_sw<VS>(VT, x, c0), pb, o0); o1 = MFMA32(lds_cat_sw<VS>(VT, 32 + x, c0), pb, o1);
                __builtin_amdgcn_sched_barrier(0);
            }
        bf16_t* op = MIX + qrow * 2048 + 1024 + head * 64 + 4 * hi;
#pragma unroll
        for (int g = 0; g < 4; ++g) {
            u32x2 w0, w1; w0.x = cvtpk(o0[4 * g] * inv, o0[4 * g + 1] * inv); w0.y = cvtpk(o0[4 * g + 2] * inv, o0[4 * g + 3] * inv);
            w1.x = cvtpk(o1[4 * g] * inv, o1[4 * g + 1] * inv); w1.y = cvtpk(o1[4 * g + 2] * inv, o1[4 * g + 3] * inv);
            *(u32x2*)(op + 8 * g) = w0; *(u32x2*)(op + 32 + 8 * g) = w1;
        }
    }
}

__device__ __forceinline__ void kv_item2(int it0, LAS unsigned char* lds, const bf16_t* RK, const bf16_t* RV, float* STATE, int tid, int wid, int lane) {
    constexpr int VS = 136, TILE = 128 * VS;
    LAS bf16_t* L = (LAS bf16_t*)lds;
    __syncthreads();
#pragma unroll
    for (int k = 0; k < 2; ++k) {
        const int it = it0 + k, bh = it >> 5, n = it & 31, b = bh >> 3, h = bh & 7; const long r0 = (long)b * SEQ + n * 128;
        stage_T<128, 128, VS>(L + (2 * k) * TILE, RK, r0, 1024, h * 128, 0, tid);
        stage_T<128, 128, VS>(L + (2 * k + 1) * TILE, RV, r0, 1024, h * 128, 0, tid);
    }
    __syncthreads();
    const int half = wid >> 2, it = it0 + half, h = (it >> 5) & 7;
    const LAS bf16_t* KT = L + (2 * half) * TILE; const LAS bf16_t* VT = KT + TILE;
    const int x = lane & 31, hi = lane >> 5, et = wid & 3;
    f32x16 acc[4];
#pragma unroll
    for (int dt = 0; dt < 4; ++dt) acc[dt] = f32x16{};
#pragma unroll
    for (int ks = 0; ks < 8; ++ks) {
        const int ea = 32 * et + x, cc = 16 * ks + 8 * hi;
        const bf16x8 A = *(const LAS bf16x8*)(VT + ea * VS + swzc(ea, cc));
#pragma unroll
        for (int dt = 0; dt < 4; ++dt) { const int da = 32 * dt + x; acc[dt] = MFMA32(A, *(const LAS bf16x8*)(KT + da * VS + swzc(da, cc)), acc[dt]); }
    }
    const float g127 = exp2f(127.0f * lg2gamma(h));
    float* sp = STATE + (size_t)it * 16384;
#pragma unroll
    for (int dt = 0; dt < 4; ++dt)
#pragma unroll
        for (int r = 0; r < 16; ++r) sp[(32 * et + crow(r, hi)) * 128 + 32 * dt + x] = acc[dt][r] * g127;
}

__device__ __forceinline__ void ro_item2(int it0, LAS unsigned char* lds, const bf16_t* RQ, const bf16_t* RK, const bf16_t* RV, const bf16_t* RG, const bf16_t* SPREV, const float* GN, bf16_t* MIX,
                                         int tid, int wid, int lane) {
    constexpr int VS = 136, TILE = 128 * VS;
    LAS bf16_t* L = (LAS bf16_t*)lds;
    __syncthreads();
#pragma unroll
    for (int k = 0; k < 2; ++k) {
        const int it = it0 + k, bh = it >> 5, n = it & 31, b = bh >> 3, h = bh & 7;
        stage_T<128, 128, VS>(L + k * TILE, RV, (long)b * SEQ + n * 128, 1024, h * 128, 0, tid);
    }
    __syncthreads();
    const int half = wid >> 2, it = it0 + half, bh = it >> 5, n = it & 31, b = bh >> 3, h = bh & 7;
    const LAS bf16_t* VT = L + half * TILE;
    const long r0 = (long)b * SEQ + n * 128;
    const int x = lane & 31, hi = lane >> 5, ct = wid & 3;
    const long qrow = r0 + 32 * ct + x;
    bf16x8 qf[8];
#pragma unroll
    for (int ks = 0; ks < 8; ++ks) qf[ks] = *(const bf16x8*)(RQ + qrow * 1024 + h * 128 + 16 * ks + 8 * hi);
    f32x16 o[4];
#pragma unroll
    for (int et = 0; et < 4; ++et) o[et] = f32x16{};
    for (int jt = 0; jt <= ct; ++jt) {
        f32x16 st = {};
        const bf16_t* kptr = RK + (r0 + 32 * jt + x) * 1024 + h * 128 + 8 * hi;
#pragma unroll
        for (int ks = 0; ks < 8; ++ks) st = MFMA32(*(const bf16x8*)(kptr + 16 * ks), qf[ks], st);
        if (jt == ct) {
#pragma unroll
            for (int r = 0; r < 16; ++r) if (crow(r, hi) > x) st[r] = 0.f;
        }
#pragma unroll
        for (int s2 = 0; s2 < 2; ++s2) {
            const bf16x8 pb = pack8(st, s2);
#pragma unroll
            for (int et = 0; et < 4; ++et) o[et] = MFMA32(lds_cat_sw<VS>(VT, 32 * et + x, 32 * jt + 16 * s2 + 4 * hi), pb, o[et]);
        }
    }
    const bf16_t* sp = SPREV + (size_t)it * 16384;
#pragma unroll
    for (int et = 0; et < 4; ++et)
#pragma unroll
        for (int ks = 0; ks < 8; ++ks) o[et] = MFMA32(*(const bf16x8*)(sp + (32 * et + x) * 128 + 16 * ks + 8 * hi), qf[ks], o[et]);
    float s1 = 0.f, s2 = 0.f;
#pragma unroll
    for (int et = 0; et < 4; ++et)
#pragma unroll
        for (int r = 0; r < 16; ++r) { s1 += o[et][r]; s2 += o[et][r] * o[et][r]; }
    s1 += __shfl_xor(s1, 32); s2 += __shfl_xor(s2, 32);
    const float mean = s1 * (1.0f / 128.0f), var = fmaxf(s2 * (1.0f / 128.0f) - mean * mean, 0.f), rstd = rsqrtf(var + EPS);
#pragma unroll
    for (int et = 0; et < 4; ++et)
#pragma unroll
        for (int g = 0; g < 4; ++g) {
            const int e0 = 32 * et + 8 * g + 4 * hi;
            const u32x2 gt = *(const u32x2*)(RG + qrow * 1024 + h * 128 + e0);
            const f32x4 gn = *(const f32x4*)(GN + h * 128 + e0);
            const float y0 = (o[et][4 * g] - mean) * rstd * gn[0] * bflo(gt.x), y1 = (o[et][4 * g + 1] - mean) * rstd * gn[1] * bfhi(gt.x);
            const float y2 = (o[et][4 * g + 2] - mean) * rstd * gn[2] * bflo(gt.y), y3 = (o[et][4 * g + 3] - mean) * rstd * gn[3] * bfhi(gt.y);
            u32x2 w; w.x = cvtpk(y0, y1); w.y = cvtpk(y2, y3);
            *(u32x2*)(MIX + qrow * 2048 + h * 128 + e0) = w;
        }
}

__device__ __forceinline__ void xa_item(int it, LAS unsigned char* lds, const bf16_t* XQ, const bf16_t* XK, bf16_t* PB, int tid, int wid, int lane) {
    const int qb = it & 31, head = (it >> 5) & 3, b = it >> 7;
    const int x = lane & 31, hi = lane >> 5;
    constexpr int KS = 136;
    LAS bf16_t* KL = (LAS bf16_t*)lds;
    const long qrow = (long)b * SEQ + qb * 128 + 32 * (wid & 3) + x;
    const bf16_t* qp = XQ + qrow * 2048 + head * 512 + 8 * hi;
    const bf16_t* ksrc = XK + (size_t)(b * MEML + (tid >> 4)) * 2048 + head * 512 + 8 * (tid & 15);
    u32x4 R[8];
#pragma unroll
    for (int i = 0; i < 8; ++i) R[i] = *(const u32x4*)(ksrc + (size_t)(32 * i) * 2048);
    f32x16 st[8];
#pragma unroll
    for (int mt = 0; mt < 8; ++mt) st[mt] = f32x16{};
#pragma unroll 1
    for (int c = 0; c < 4; ++c) {
        __syncthreads();
#pragma unroll
        for (int i = 0; i < 8; ++i) *(LAS u32x4*)(KL + ((tid >> 4) + 32 * i) * KS + 8 * (tid & 15)) = R[i];
        if (c < 3) {
#pragma unroll
            for (int i = 0; i < 8; ++i) R[i] = *(const u32x4*)(ksrc + (size_t)(32 * i) * 2048 + (c + 1) * 128);
        }
        __syncthreads();
        if (wid < 4) {
#pragma unroll 2
            for (int ks = 0; ks < 8; ++ks) {
                const bf16x8 qv = *(const bf16x8*)(qp + c * 128 + 16 * ks);
#pragma unroll
                for (int mt = 0; mt < 8; ++mt) st[mt] = MFMA32(*(const LAS bf16x8*)(KL + (32 * mt + x) * KS + 16 * ks + 8 * hi), qv, st[mt]);
            }
        }
    }
    if (wid < 4) {
        float mx = -1e30f;
#pragma unroll
        for (int mt = 0; mt < 8; ++mt)
#pragma unroll
            for (int r = 0; r < 16; ++r) mx = fmaxf(mx, st[mt][r]);
        mx = fmaxf(mx, __shfl_xor(mx, 32));
        float sum = 0.f;
#pragma unroll
        for (int mt = 0; mt < 8; ++mt)
#pragma unroll
            for (int r = 0; r < 16; ++r) { const float p = __builtin_amdgcn_exp2f(st[mt][r] - mx); st[mt][r] = p; sum += p; }
        sum += __shfl_xor(sum, 32);
        const float inv = 1.0f / sum;
        bf16_t* op = PB + qrow * 1024 + head * 256 + 4 * hi;
#pragma unroll
        for (int mt = 0; mt < 8; ++mt)
#pragma unroll
            for (int g = 0; g < 4; ++g) { u32x2 w; w.x = cvtpk(st[mt][4 * g] * inv, st[mt][4 * g + 1] * inv); w.y = cvtpk(st[mt][4 * g + 2] * inv, st[mt][4 * g + 3] * inv); *(u32x2*)(op + 32 * mt + 8 * g) = w; }
    }
}

#define XB_TMO      128
#define XB_XCNT(j)  (256  + 64 * (j))
#define XB_XSUB(j)  (1280 + 64 * (j))
#define XB_XGEN(j)  (2304 + 64 * (j))
#define XB_TOP      3328
#define XB_TOPGEN   3392
#define XCD_BAR_WORDS 3456
#define XB_SPIN_CAP (1u << 18)

__device__ __forceinline__ unsigned xb_ld(unsigned* p)              { return __hip_atomic_load(p, __ATOMIC_RELAXED, __HIP_MEMORY_SCOPE_AGENT); }
__device__ __forceinline__ unsigned xb_add(unsigned* p, unsigned v) { return __hip_atomic_fetch_add(p, v, __ATOMIC_RELAXED, __HIP_MEMORY_SCOPE_AGENT); }
__device__ __forceinline__ unsigned xb_xcc_id() { return (unsigned)__builtin_amdgcn_s_getreg((3 << 11) | 20) & 0xFu; }
#define XB_SPIN(cond, bar) do { unsigned _sp = 0; while (cond) { __builtin_amdgcn_s_sleep(1); \
    if ((++_sp & 255u) == 0u) { if (xb_ld(&(bar)[XB_TMO])) break; if (_sp > XB_SPIN_CAP) { atomicAdd(&(bar)[XB_TMO], 1u); break; } } } } while (0)

struct XcdBarrier {
    unsigned* bar; unsigned x;
    volatile LAS unsigned* st;
};

__device__ __forceinline__ XcdBarrier xcd_barrier_post(unsigned* bar, volatile LAS unsigned* st) {
    XcdBarrier b; b.bar = bar; b.x = xb_xcc_id(); b.st = st;
    if (threadIdx.x == 0) (void)xb_add(&bar[XB_XCNT(b.x)], 1u);
    return b;
}
__device__ __forceinline__ void xcd_barrier_complete(unsigned* bar, unsigned x, unsigned& nloc, unsigned& nx) {
    const unsigned G = gridDim.x * gridDim.y * gridDim.z;
    unsigned sum, cnt, mine, sp = 0u;
    for (;;) {
        sum = 0u; cnt = 0u; mine = 0u;
#pragma unroll
        for (unsigned j = 0; j < 16; ++j) { const unsigned c = xb_ld(&bar[XB_XCNT(j)]); sum += c; cnt += (c > 0u) ? 1u : 0u; mine = (j == x) ? c : mine; }
        if (sum == G) break;
        __builtin_amdgcn_s_sleep(1);
        if ((++sp & 255u) == 0u) { if (xb_ld(&bar[XB_TMO])) break; if (sp > XB_SPIN_CAP) { atomicAdd(&bar[XB_TMO], 1u); break; } }
    }
    nloc = mine > 0u ? mine : 1u; nx = cnt > 0u ? cnt : 1u;
}

__device__ __forceinline__ void xcd_barrier(const XcdBarrier& b) {
    asm volatile("s_waitcnt vmcnt(0)" ::: "memory");
    __syncthreads();
    if (threadIdx.x == 0) {
        unsigned* bar = b.bar;
        __builtin_amdgcn_s_waitcnt(0);
        unsigned nloc = b.st[0], nx = b.st[1];
        if (nloc == 0u) { xcd_barrier_complete(bar, b.x, nloc, nx); b.st[0] = nloc; b.st[1] = nx; }
        const unsigned old = xb_add(&bar[XB_XSUB(b.x)], 1u);
        const unsigned gen = old / nloc;
        if (old + 1u == (gen + 1u) * nloc) {
            __builtin_amdgcn_fence(__ATOMIC_RELEASE, "agent");
            asm volatile("s_waitcnt vmcnt(0)" ::: "memory");
            const unsigned og = xb_add(&bar[XB_TOP], 1u);
            const unsigned tg = og / nx;
            if (og + 1u == (tg + 1u) * nx) xb_add(&bar[XB_TOPGEN], 1u);
            else XB_SPIN(xb_ld(&bar[XB_TOPGEN]) == tg, bar);
            __builtin_amdgcn_fence(__ATOMIC_ACQUIRE, "agent");
            xb_add(&bar[XB_XGEN(b.x)], 1u);
            asm volatile("s_waitcnt vmcnt(0)" ::: "memory");
        } else {
            XB_SPIN(xb_ld(&bar[XB_XGEN(b.x)]) == gen, bar);
            __builtin_amdgcn_fence(__ATOMIC_ACQUIRE, "agent");
            asm volatile("s_waitcnt vmcnt(0)" ::: "memory");
        }
    }
    __syncthreads();
}

struct Args { const float* in[21]; float* out; unsigned char* ws; int ph_lo, ph_hi, sub, pad; };

__global__ void __launch_bounds__(512, 2) mk_fwd(Args a) {
    extern __shared__ __attribute__((aligned(16))) unsigned char lds_raw[];
    LAS unsigned char* lds = (LAS unsigned char*)lds_raw;
    const int tid = threadIdx.x, lane = tid & 63, wid = __builtin_amdgcn_readfirstlane(tid >> 6);
    const int G = gridDim.x, bid = blockIdx.x;
    unsigned char* ws = a.ws;
    float* SSQ0 = (float*)(ws + WS_SSQ0); float* SSQ1 = (float*)(ws + WS_SSQ1); float* SSQ2 = (float*)(ws + WS_SSQ2); float* SSQ3 = (float*)(ws + WS_SSQ3);
    float* SSQ4 = (float*)(ws + WS_SSQ4); float* SSQM = (float*)(ws + WS_SSQM);
    float* C128 = (float*)(ws + WS_C128); float* S128 = (float*)(ws + WS_S128); float* C64 = (float*)(ws + WS_C64); float* S64 = (float*)(ws + WS_S64);
    bf16_t* MEMB = (bf16_t*)(ws + WS_MEMB); bf16_t* XK = (bf16_t*)(ws + WS_XK); bf16_t* XVT = (bf16_t*)(ws + WS_XVT);
    bf16_t* W1GU = (bf16_t*)(ws + WS_W1GU); bf16_t* W1D = (bf16_t*)(ws + WS_W1D); bf16_t* WIN = (bf16_t*)(ws + WS_WIN); bf16_t* WOUT = (bf16_t*)(ws + WS_WOUT);
    bf16_t* WQ = (bf16_t*)(ws + WS_WQ); bf16_t* WKV = (bf16_t*)(ws + WS_WKV); bf16_t* WO = (bf16_t*)(ws + WS_WO); bf16_t* W2GU = (bf16_t*)(ws + WS_W2GU); bf16_t* W2D = (bf16_t*)(ws + WS_W2D);
    bf16_t* XB = (bf16_t*)(ws + WS_XB); bf16_t* MIX = (bf16_t*)(ws + WS_MIX);
    unsigned char* r1 = ws + WS_R1;
    bf16_t* ACT = (bf16_t*)(r1 + R1_ACT); bf16_t* RQ = (bf16_t*)(r1 + R1_RQ); bf16_t* RK = (bf16_t*)(r1 + R1_RK); bf16_t* RV = (bf16_t*)(r1 + R1_RV); bf16_t* RG = (bf16_t*)(r1 + R1_RG);
    bf16_t* SQ = (bf16_t*)(r1 + R1_SQ); bf16_t* SK = (bf16_t*)(r1 + R1_SK); bf16_t* SV = (bf16_t*)(r1 + R1_SV); float* STATE = (float*)(r1 + R1_STATE); bf16_t* SPREV = (bf16_t*)(r1 + R1_SPREV);
    bf16_t* XQ = (bf16_t*)(r1 + R1_XQ); bf16_t* XO = (bf16_t*)(r1 + R1_XO);
    const int lo = a.ph_lo, hi_ph = a.ph_hi;
#ifndef PHMASK
#define PHMASK 0xffffffffu
#endif
#define IN(k) (((PHMASK >> (k)) & 1u) && lo <= (k) && (k) < hi_ph)
#ifndef PHREP
#define PHREP -1
#endif
#ifndef XSYNC
#define XSYNC 0
#endif
#ifndef CG_ALL
#define CG_ALL 0
#endif
#define PM_EVEN (8 * ((bid & 7) >> 1) + ((bid >> 3) & 7))
#define PM_WIN  (8 * ((bid & 7) >> 1) + (((bid >> 3) + 4 * (bid & 1)) & 7))
#define RS_TABLE(pm0_, ssq_) do { if (tid < 256) ((LAS float*)(lds + 131072))[tid] = rsqrtf((ssq_)[(pm0_) * 256 + tid] * (1.0f / D) + EPS); __syncthreads(); } while (0)
#define SEAM(k) do { if (IN(k) && IN((k) + 1)) { if (CG_ALL || lo < 0) cg::this_grid().sync(); else xcd_barrier(xbar); } } while (0)
    XcdBarrier xbar; xbar.bar = (unsigned*)(ws + WS_CTL); xbar.x = 0; xbar.st = nullptr;
    if (hi_ph - lo > 1) {
        volatile LAS unsigned* bst = (volatile LAS unsigned*)(lds + LDS_BAR_OFF);
        if (tid < 2) bst[tid] = 0u;
        __syncthreads();
        xbar = xcd_barrier_post((unsigned*)(ws + WS_CTL), bst);
    }

    if (IN(0)) {
        LAS float* scr = (LAS float*)(lds + wid * 16640);
        const int gw = bid * 8 + wid, ngw = G * 8;
#if !X_LAST
        for (int r = gw; r < T; r += 4 * ngw) rows_to_bf16<4>(a.in[0], XB, SSQ0, r, ngw, T, lane);
        for (int r = gw; r < MEMT; r += ngw) rows_to_bf16<1>(a.in[1], MEMB, SSQM, r, ngw, MEMT, lane);
#endif
        if (G == 256) { tr_all(a.in, ws, scr, gw, ngw, lane, TrRanges{W2GU_SPLIT, 21888, 13184, 15232, WO_IN_P0 ? 15232 : 0, WO_IN_P0 ? 16256 : 0}); tr_all(a.in, ws, scr, gw, ngw, lane, TrRanges{0, 5632, 0, 0, 0, 0}); }
        else tr_all(a.in, ws, scr, gw, ngw, lane, TrRanges{0, TR_NIT, 0, 0, 0, 0});
#if X_LAST
        for (int r = gw; r < T; r += 4 * ngw) rows_to_bf16<4>(a.in[0], XB, SSQ0, r, ngw, T, lane);
        for (int r = gw; r < MEMT; r += ngw) rows_to_bf16<1>(a.in[1], MEMB, SSQM, r, ngw, MEMT, lane);
#endif
        const int gt = bid * 512 + tid, ngt = G * 512;
        for (int i = gt; i < T; i += ngt) { SSQ1[i] = 0.f; SSQ2[i] = 0.f; SSQ3[i] = 0.f; SSQ4[i] = 0.f; }
        for (int i = gt; i < SEQ * 64; i += ngt) {
            const int pos = i >> 6, fi = i & 63;
            {   const float inv = powf(10000.0f, -(float)fi * (1.0f / 64.0f)); const float ang = (float)pos * inv;
                double t = (double)ang * 0.15915494309189535; t -= floor(t + 0.5); const float ar = (float)(t * 6.283185307179586);
                C128[i] = __cosf(ar); S128[i] = __sinf(ar); }
            if (fi < 32) { const float inv = powf(10000.0f, -(float)fi * (1.0f / 32.0f)); const float ang = (float)pos * inv;
                double t = (double)ang * 0.15915494309189535; t -= floor(t + 0.5); const float ar = (float)(t * 6.283185307179586);
                C64[pos * 32 + fi] = __cosf(ar); S64[pos * 32 + fi] = __sinf(ar); }
        }
    }
    SEAM(0);
    if (IN(1)) {
        { pg8::Gemm g{XB, W1GU, T, 2 * FF, D}; pg8::StaticOrder S; S.init(T, 2 * FF, G, bid); RS_TABLE(PM_EVEN, SSQ0);
          EpiSwiGLU E{ACT}; pg8::gemm_phase<EpiSwiGLU, pg8::StaticOrder, GEMM_ALIGNM, GEMM_SP2>(lds, g, S, E); }
        { pg8::Gemm g{MEMB, WKV, MEMT, 2 * D, D}; pg8::StaticOrder S; S.init(MEMT, 2 * D, G, (G == 256) ? ((bid + 128) & 255) : bid); EpiKV E{XK, XVT, SSQM};
          pg8::gemm_phase<EpiKV, pg8::StaticOrder, GEMM_ALIGNM, GEMM_SP2>(lds, g, S, E); }
        if (G == 256 && bid >= 160) { __syncthreads(); tr_all(a.in, ws, (LAS float*)(lds + wid * 16640), (bid - 160) * 8 + wid, 96 * 8, lane, TrRanges{5632, 11136, WO_IN_P0 ? 0 : 15232, WO_IN_P0 ? 0 : 16256, 0, 0}); }
    }
    SEAM(1);
    if (IN(2)) { pg8::Gemm g{ACT, W1D, T, D, FF}; pg8::StaticOrder S; S.init(T, D, G, bid); EpiResid<P2_BASE_F32, false> E{a.in[0], nullptr, XB, a.sub ? (float*)(ws + WS_SSQX) : SSQ1, 0.5f};
        pg8::gemm_phase<EpiResid<P2_BASE_F32, false>, pg8::StaticOrder, GEMM_ALIGN1, GEMM_SP2>(lds, g, S, E); }
    SEAM(2);
    if (IN(3)) { pg8::Gemm g{XB, WIN, T, INC, D}; pg8::StaticOrder S; S.init(T, INC, G, bid); RS_TABLE(PM_WIN, SSQ1); EpiWin E{SSQ1, RQ, RK, RV, RG, SQ, SK, SV, C128, S128, C64, S64};
        pg8::gemm_phase<EpiWin, pg8::StaticOrder, GEMM_ALIGNM, GEMM_SP2>(lds, g, S, E);
        if (G == 256 && bid >= 160) { __syncthreads(); tr_all(a.in, ws, (LAS float*)(lds + wid * 16640), (bid - 160) * 8 + wid, 96 * 8, lane, TrRanges{11136, 13184, 16256, W2GU_SPLIT, 0, 0});
            __syncthreads();
            if (bid < 224) { pg8::Gemm g2{(const bf16_t*)(ws + WS_WO), XVT, 4 * 2048, 8 * MEML, 512}; VwoOrder S2{bid - 160}; EpiVWo E2{(bf16_t*)(ws + WS_VWOT)};
                pg8::gemm_phase<EpiVWo, VwoOrder, true, GEMM_SP2>(lds, g2, S2, E2); } }
}
    SEAM(3);
    if (IN(4)) {
        for (int it = bid; it < 256; it += G) swa_item(it, lds, SQ, SK, SV, a.in[9], MIX, tid, wid, lane);
        for (int it = 2 * bid; it < 512; it += 2 * G) kv_item2(it, lds, RK, RV, STATE, tid, wid, lane);
    }
    SEAM(4);
    if (IN(5)) {
        for (int idx = bid * 512 + tid; idx < 16 * 16384; idx += G * 512) {
            const int bh = idx >> 14, ed = idx & 16383, h = bh & 7;
            const float lg = lg2gamma(h), gm = exp2f(lg), gC = exp2f(128.0f * lg);
            float v[32];
#pragma unroll
            for (int n = 0; n < 32; ++n) v[n] = STATE[(size_t)(bh * 32 + n) * 16384 + ed];
            float run = 0.f;
#pragma unroll
            for (int n = 0; n < 32; ++n) { SPREV[(size_t)(bh * 32 + n) * 16384 + ed] = (bf16_t)(cvtpk(gm * run, 0.f) & 0xffffu); run = run * gC + v[n]; }
        }
    }
    SEAM(5);
    if (IN(6)) { for (int it = 2 * bid; it < 512; it += 2 * G) ro_item2(it, lds, RQ, RK, RV, RG, SPREV, a.in[8], MIX, tid, wid, lane); }
    SEAM(6);
    if (IN(7)) { pg8::Gemm g{MIX, WOUT, T, D, D}; pg8::StaticOrder S; S.init(T, D, G, bid); EpiResid<false, false> E{nullptr, nullptr, XB, SSQ2, 1.0f};
        pg8::gemm_phase<EpiResid<false, false>, pg8::StaticOrder, GEMM_ALIGN1, GEMM_SP2>(lds, g, S, E); }
    SEAM(7);
    if (IN(8)) { pg8::Gemm g{XB, WQ, T, D, D}; pg8::StaticOrder S; S.init(T, D, G, bid); RS_TABLE(PM_EVEN, SSQ2); EpiScale E{XQ, SSQ2, 0.04419417382415922f * LOG2E};
        pg8::gemm_phase<EpiScale, pg8::StaticOrder, GEMM_ALIGN1, GEMM_SP2>(lds, g, S, E); }
    SEAM(8);
    if (IN(9)) { for (int it = bid; it < 256; it += G) xa_item(it, lds, XQ, XK, XO, tid, wid, lane); }
    SEAM(9);
    if (IN(10)) { pg8::Gemm g{XO, (const bf16_t*)(ws + WS_VWOT), T, 2 * D, 2 * 512}; OutOrder S; S.b.init(T, D, G, bid); EpiResid<false, false> E{nullptr, nullptr, XB, SSQ3, 1.0f};
        pg8::gemm_phase<EpiResid<false, false>, OutOrder, GEMM_ALIGN1, GEMM_SP2>(lds, g, S, E); }
    SEAM(10);
    if (IN(11)) { pg8::Gemm g{XB, W2GU, T, 2 * FF, D}; pg8::StaticOrder S; S.init(T, 2 * FF, G, bid); RS_TABLE(PM_EVEN, SSQ3);
        EpiSwiGLU E{ACT}; pg8::gemm_phase<EpiSwiGLU, pg8::StaticOrder, GEMM_ALIGNM, GEMM_SP2>(lds, g, S, E);
        if (G == 256 && bid >= 128) { __syncthreads(); tr_all(a.in, ws, (LAS float*)(lds + wid * 16640), (bid - 128) * 8 + wid, 128 * 8, lane, TrRanges{21888, 24704, 0, 0, 0, 0}); } }
    SEAM(11);
#ifndef FUSE_FINAL
#define FUSE_FINAL 1
#endif
    const bool fuse_final = FUSE_FINAL && G == 256 && hi_ph - lo > 1;
    if (IN(12)) { pg8::Gemm g{ACT, W2D, T, D, FF}; pg8::StaticOrder S; S.init(T, D, G, bid);
        if (fuse_final) { EpiFinal E{a.out, XB, (float*)(ws + WS_XBUF), (unsigned*)(ws + WS_CTL + 16384), a.in[20], 0.5f}; pg8::gemm_phase<EpiFinal, pg8::StaticOrder, false, GEMM_SP2>(lds, g, S, E); }
        }
    if (!fuse_final) SEAM(12);
#undef IN
#undef SEAM
}

extern "C" void kernel_launch(void* const* d_in, const int* in_sizes, int n_in, void* d_out, int out_size, void* d_ws, size_t ws_size, hipStream_t stream) {
    static int grid = 0;
    if (grid == 0) {
        if (n_in != 21 || ws_size < WS_END) { fprintf(stderr, "kernel_launch: unexpected inputs (n_in %d, ws %zu)\n", n_in, ws_size); grid = -1; return; }
        int dev = 0, cus = 0, per_cu = 0;
        hipGetDevice(&dev); hipDeviceGetAttribute(&cus, hipDeviceAttributeMultiprocessorCount, dev);
        hipFuncSetAttribute((const void*)mk_fwd, hipFuncAttributeMaxDynamicSharedMemorySize, LDS_BYTES);
        hipOccupancyMaxActiveBlocksPerMultiprocessor(&per_cu, (const void*)mk_fwd, 512, LDS_BYTES);
        if (per_cu < 1) { fprintf(stderr, "kernel_launch: occupancy query says %d blocks per CU\n", per_cu); per_cu = 1; }
        (void)hipGetLastError();
        if (cus < 256) { fprintf(stderr, "kernel_launch: built for a 256-CU MI355X (one workgroup per CU), device reports %d CUs; nothing launched\n", cus); grid = -1; return; }
        grid = 256;
    }
    if (grid < 0) return;
    Args a{};
    for (int i = 0; i < 21; ++i) a.in[i] = (const float*)d_in[i];
    a.out = (float*)d_out; a.ws = (unsigned char*)d_ws;
#if MK_SINGLE
    a.ph_lo = 0; a.ph_hi = NPH;
    hipMemsetAsync((unsigned char*)d_ws + WS_CTL, 0, CTL_BYTES, stream);
    void* args[] = {&a};
    hipError_t e = hipLaunchCooperativeKernel((const void*)mk_fwd, dim3(grid), dim3(512), args, LDS_BYTES, stream);
    if (e != hipSuccess) fprintf(stderr, "cooperative launch failed: %s (grid %d)\n", hipGetErrorString(e), grid);
#else
#ifndef FWD_REPS
#define FWD_REPS 1
#endif
    for (int fr_ = 0; fr_ < FWD_REPS; ++fr_)
    for (int p = 0; p < NPH; ++p) { a.ph_lo = p; a.ph_hi = p + 1; const int reps = ((PHREP) == p || ((PHREP) == 456 && p >= 4 && p <= 6)) ? 2 : 1;
        for (int r = 0; r < reps; ++r) { a.sub = r; hipLaunchKernelGGL(mk_fwd, dim3(grid), dim3(512), LDS_BYTES, stream, a); } a.sub = 0; }
#ifdef NOOP_LAUNCHES
    for (int r = 0; r < NOOP_LAUNCHES; ++r) { a.ph_lo = 20; a.ph_hi = 21; hipLaunchKernelGGL(mk_fwd, dim3(grid), dim3(512), LDS_BYTES, stream, a); }
#endif
#endif
}
```
